# Optimizing an MI355X kernel written in HIP

```python
import jax, jax.numpy as jnp
from jax import lax
import numpy as np


D_MODEL = 1024
BATCH = 4
SEQ = 8192
DEPTH = 2

NORM_EPS = 1e-5
N_EVEN = (DEPTH + 1) // 2
N_ODD = DEPTH // 2

POOL_WINDOWS = (2, 4, 8, 16)
N_POOL_GROUPS = len(POOL_WINDOWS)
POOL_WIDTH = D_MODEL
POOL_GC = POOL_WIDTH // N_POOL_GROUPS
CONV_WIDTH = D_MODEL
CONV_K = 3
EVEN_WIDTH = POOL_WIDTH + CONV_WIDTH
EVEN_IN = POOL_WIDTH + 3 * CONV_WIDTH + EVEN_WIDTH

HEAD_DIM = 64
N_HEADS = D_MODEL // HEAD_DIM
N_KV_HEADS = 2
GROUP = N_HEADS // N_KV_HEADS
ATTN_WIDTH = N_HEADS * HEAD_DIM
KV_WIDTH = N_KV_HEADS * HEAD_DIM
ODD_IN = ATTN_WIDTH + 2 * KV_WIDTH + ATTN_WIDTH
WINDOW = 128
Q_BLOCK = 128
ROPE_THETA = 500000.0
ROT_DIMS = HEAD_DIM // 4

kernel_name = "hybrid_pool_shortconv_swa_sink_trunk"


def rms_norm(x, g):
    x32 = x.astype(jnp.float32)
    r = x32 * lax.rsqrt(jnp.mean(x32 * x32, axis=-1, keepdims=True) + NORM_EPS)
    return (r * g.astype(jnp.float32)).astype(x.dtype)


def shift_right(u, k):
    s = u.shape[1]
    return jnp.pad(u, ((0, 0), (k, 0), (0, 0)))[:, :s]


def causal_multiscale_pool(u):
    s = u.shape[1]
    u32 = u.astype(jnp.float32)
    cs = jnp.cumsum(u32, axis=1)
    t = jnp.arange(s)
    outs = []
    for g, w in enumerate(POOL_WINDOWS):
        cg = cs[:, :, g]
        window_sum = cg - shift_right(cg, w)
        count = jnp.minimum(t + 1, w).astype(jnp.float32)[None, :, None]
        outs.append(window_sum / count - u32[:, :, g])
    return jnp.stack(outs, axis=2).astype(u.dtype)


def even_mixer(y, w_in, w_pool, pool_scale, conv_w, w_out):
    b, s, _ = y.shape
    proj = y @ w_in
    u_a, gate_b, gate_c, h_c, z = jnp.split(
        proj, [POOL_WIDTH, POOL_WIDTH + CONV_WIDTH, POOL_WIDTH + 2 * CONV_WIDTH,
               POOL_WIDTH + 3 * CONV_WIDTH], axis=-1)
    pooled = causal_multiscale_pool(u_a.reshape(b, s, N_POOL_GROUPS, POOL_GC))
    a = jnp.einsum("bsgc,gcd->bsgd", pooled, w_pool).reshape(b, s, POOL_WIDTH) * pool_scale
    cu = gate_c * h_c
    v = conv_w[2] * cu + conv_w[1] * shift_right(cu, 1) + conv_w[0] * shift_right(cu, 2)
    bo = gate_b * v
    out = jnp.concatenate([a, bo], axis=-1) * jax.nn.silu(z)
    return out @ w_out


def rope_tables(positions):
    inv_freq = ROPE_THETA ** (-jnp.arange(0, ROT_DIMS, 2, dtype=jnp.float32) / ROT_DIMS)
    ang = positions.astype(jnp.float32)[..., None] * inv_freq
    return jnp.cos(ang)[:, :, None, :], jnp.sin(ang)[:, :, None, :]


def partial_rotary(x, cos, sin):
    half = ROT_DIMS // 2
    c = cos.astype(x.dtype)
    sn = sin.astype(x.dtype)
    x1 = x[..., :half]
    x2 = x[..., half:ROT_DIMS]
    return jnp.concatenate([x1 * c - x2 * sn, x2 * c + x1 * sn, x[..., ROT_DIMS:]], axis=-1)


def band_mask(nb):
    i = jnp.arange(Q_BLOCK)[:, None]
    j = jnp.arange(2 * Q_BLOCK)[None, :]
    diff = i + Q_BLOCK - j
    band = (diff >= 0) & (diff < WINDOW)
    blk = jnp.arange(nb)[:, None, None]
    return band[None] & ((blk > 0) | (j[None] >= Q_BLOCK))


def sliding_window_gqa_sinks(q, k, v, sinks):
    b, s, _, _ = q.shape
    nb = s // Q_BLOCK
    qb = q.reshape(b, nb, Q_BLOCK, N_KV_HEADS, GROUP, HEAD_DIM)

    def with_prev(t):
        tb = t.reshape(b, nb, Q_BLOCK, N_KV_HEADS, HEAD_DIM)
        prev = jnp.pad(tb, ((0, 0), (1, 0), (0, 0), (0, 0), (0, 0)))[:, :nb]
        return jnp.concatenate([prev, tb], axis=2)

    kb = with_prev(k)
    vb = with_prev(v)
    scale = HEAD_DIM ** -0.5
    scores = jnp.einsum("bnqkgd,bnskd->bnkgqs", qb, kb,
                        preferred_element_type=jnp.float32) * scale
    mask = band_mask(nb)[None, :, None, None]
    scores = jnp.where(mask, scores, -jnp.inf)
    sink = sinks.astype(jnp.float32).reshape(1, 1, N_KV_HEADS, GROUP, 1, 1)
    m = jnp.maximum(jnp.max(scores, axis=-1, keepdims=True), sink)
    p = jnp.exp(scores - m)
    denom = jnp.sum(p, axis=-1, keepdims=True) + jnp.exp(sink - m)
    p = (p / denom).astype(v.dtype)
    out = jnp.einsum("bnkgqs,bnskd->bnqkgd", p, vb)
    return out.reshape(b, s, ATTN_WIDTH)


def odd_mixer(y, cos, sin, w_in, b_in, sinks, w_out, b_out):
    b, s, _ = y.shape
    proj = y @ w_in + b_in
    q, k, v, z = jnp.split(
        proj, [ATTN_WIDTH, ATTN_WIDTH + KV_WIDTH, ATTN_WIDTH + 2 * KV_WIDTH], axis=-1)
    q = partial_rotary(q.reshape(b, s, N_HEADS, HEAD_DIM), cos, sin)
    k = partial_rotary(k.reshape(b, s, N_KV_HEADS, HEAD_DIM), cos, sin)
    v = v.reshape(b, s, N_KV_HEADS, HEAD_DIM)
    attn = sliding_window_gqa_sinks(q, k, v, sinks)
    return (attn * jax.nn.silu(z)) @ w_out + b_out


def setup_inputs(seed: int = 0) -> dict:
    key = jax.random.key(seed)
    ks = jax.random.split(key, 16)
    nrm = jax.random.normal
    f32 = jnp.float32
    x = nrm(ks[0], (BATCH, SEQ, D_MODEL), f32)
    positions = jnp.broadcast_to(jnp.arange(SEQ, dtype=jnp.int32), (BATCH, SEQ))
    norm_g = 1.0 + 0.02 * nrm(ks[1], (DEPTH, D_MODEL), f32)
    w_in_even = nrm(ks[2], (N_EVEN, D_MODEL, EVEN_IN), f32) * D_MODEL ** -0.5
    w_pool = nrm(ks[3], (N_EVEN, N_POOL_GROUPS, POOL_GC, POOL_GC), f32) * POOL_GC ** -0.5
    pool_scale = 1.0 + 0.02 * nrm(ks[4], (N_EVEN, POOL_WIDTH), f32)
    conv_w = nrm(ks[5], (N_EVEN, CONV_K, CONV_WIDTH), f32) * CONV_K ** -0.5
    w_out_even = nrm(ks[6], (N_EVEN, EVEN_WIDTH, D_MODEL), f32) * EVEN_WIDTH ** -0.5
    w_in_odd = nrm(ks[7], (N_ODD, D_MODEL, ODD_IN), f32) * D_MODEL ** -0.5
    b_in_odd = 0.02 * nrm(ks[8], (N_ODD, ODD_IN), f32)
    attn_sinks = nrm(ks[9], (N_ODD, N_HEADS), f32)
    w_out_odd = nrm(ks[10], (N_ODD, ATTN_WIDTH, D_MODEL), f32) * ATTN_WIDTH ** -0.5
    b_out_odd = 0.02 * nrm(ks[11], (N_ODD, D_MODEL), f32)
    final_norm_g = 1.0 + 0.02 * nrm(ks[12], (D_MODEL,), f32)
    return {"x": x, "positions": positions, "norm_g": norm_g,
            "w_in_even": w_in_even, "w_pool": w_pool, "pool_scale": pool_scale,
            "conv_w": conv_w, "w_out_even": w_out_even,
            "w_in_odd": w_in_odd, "b_in_odd": b_in_odd, "attn_sinks": attn_sinks,
            "w_out_odd": w_out_odd, "b_out_odd": b_out_odd,
            "final_norm_g": final_norm_g}


def reference(x, positions, norm_g, w_in_even, w_pool, pool_scale, conv_w, w_out_even,
              w_in_odd, b_in_odd, attn_sinks, w_out_odd, b_out_odd, final_norm_g):
    cos, sin = rope_tables(positions)
    h = x
    for layer in range(DEPTH):
        y = rms_norm(h, norm_g[layer])
        i = layer // 2
        if layer % 2 == 0:
            h = h + even_mixer(y, w_in_even[i], w_pool[i], pool_scale[i], conv_w[i],
                               w_out_even[i])
        else:
            h = h + odd_mixer(y, cos, sin, w_in_odd[i], b_in_odd[i], attn_sinks[i],
                              w_out_odd[i], b_out_odd[i])
    return rms_norm(h, final_norm_g)
```

```cpp
#include <hip/hip_runtime.h>
#include <hip/hip_cooperative_groups.h>
#include <cstdio>
#include <cstdint>
#include <cmath>
namespace cg = cooperative_groups;

#ifndef PROBE_MASK
#define PROBE_MASK 0
#endif
#ifndef MK_N_LAUNCHES
#define MK_N_LAUNCHES 1
#endif

#define LAS __attribute__((address_space(3)))
#define GAS __attribute__((address_space(1)))
typedef unsigned short bf16_t;
typedef short bf16x8 __attribute__((ext_vector_type(8)));
typedef short s16x4 __attribute__((ext_vector_type(4)));
typedef float f32x4 __attribute__((ext_vector_type(4)));
typedef float f32x16 __attribute__((ext_vector_type(16)));
typedef unsigned u32x4 __attribute__((ext_vector_type(4)));
typedef unsigned u32x2 __attribute__((ext_vector_type(2)));

constexpr int BATCH = 4, SEQ = 8192, D = 1024, M = BATCH * SEQ;
constexpr int EVEN_IN = 6144, EVEN_W = 2048, ODD_IN = 2304;
constexpr int NHEAD = 16, HD = 64;
constexpr float EPS = 1e-5f;
constexpr float LOG2E = 1.4426950408889634f;
constexpr float C2 = 0.125f * LOG2E;

constexpr size_t MiB = 1u << 20;
constexpr size_t WS_SS1 = 0;
constexpr size_t WS_SS2 = 2 * MiB;
constexpr size_t WS_COS = 4 * MiB;
constexpr size_t WS_ROPEC = 5 * MiB, WS_ROPES = 6 * MiB;
constexpr size_t WS_WT1 = 8 * MiB, WS_WT2 = 21 * MiB, WS_WT3 = 25 * MiB, WS_WT4 = 30 * MiB;
constexpr size_t WS_XN = 32 * MiB;
constexpr size_t WS_PROJ1 = 96 * MiB;
constexpr size_t WS_ATT = 240 * MiB;
constexpr size_t WS_CUS = 368 * MiB;
constexpr size_t WS_GZS = 372 * MiB;
constexpr size_t WS_U0 = 376 * MiB;
constexpr size_t WS_Z0 = 384 * MiB;
constexpr size_t WS_UT = 392 * MiB;
constexpr size_t WS_END = 400 * MiB;

__device__ __forceinline__ unsigned cvt_pk_bf16(float lo, float hi) { unsigned r; asm volatile("v_cvt_pk_bf16_f32 %0, %1, %2" : "=v"(r) : "v"(lo), "v"(hi)); return r; }
__device__ __forceinline__ float bf_lo(unsigned w) { return __uint_as_float(w << 16); }
__device__ __forceinline__ float bf_hi(unsigned w) { return __uint_as_float(w & 0xffff0000u); }
__device__ __forceinline__ u32x4 pack8v(const float (&f)[8]) { u32x4 w; w.x = cvt_pk_bf16(f[0], f[1]); w.y = cvt_pk_bf16(f[2], f[3]); w.z = cvt_pk_bf16(f[4], f[5]); w.w = cvt_pk_bf16(f[6], f[7]); return w; }
__device__ __forceinline__ float silu_f(float z) { return z * __builtin_amdgcn_rcpf(1.0f + __builtin_amdgcn_exp2f(-LOG2E * z)); }

namespace pg8 {
constexpr int BM = 256, BK = 64, HALF = 128, HTB = HALF * BK * 2, STAGE_BYTES = 8 * HTB, NXCD = 8, WGM = 8;
__host__ __device__ __forceinline__ int lds_byte(int r, int c) { const int st = (r >> 4) * 2 + (c >> 5), rr = r & 15, cc = c & 31, ob = rr * 64 + cc * 2; return st * 1024 + (ob ^ (((ob >> 9) & 1) << 5)); }
__host__ __device__ __forceinline__ void stage_rc(int b, int& R, int& C) { const int st = b / 1024, sb = b % 1024, swz = sb ^ (((sb >> 9) & 1) << 5); R = (st >> 1) * 16 + swz / 64; C = (st & 1) * 32 + (swz % 64) / 2; }
__host__ __device__ __forceinline__ int perm32(int rho) { const int n = rho >> 4, i = rho & 15; return 8 * (i >> 2) + 4 * n + (i & 3); }

struct Unit { int pm, pn, idx, half; };
struct Gemm { const bf16_t* A; const bf16_t* Bt; int M, N, K; size_t a_pn_stride; };

struct StaticOrder {
    int nM, nN, nwg, G, c;
    __host__ __device__ void init(int M_, int N_, int G_, int c_) { nM = M_ / BM; nN = N_ / BM; nwg = nM * nN; G = G_; c = c_; }
    int tail_round = -1;
    __host__ __device__ bool next(int i, Unit& u) const {
        u.half = -1;
        int wgid;
        if (tail_round >= 0 && i >= tail_round) {
            if (i > tail_round) return false;
            const int xcd = c & 7, k = c >> 3;
            wgid = xcd * (nwg / NXCD) + tail_round * 32 + (k >> 1); u.half = k & 1;
        } else {
        const long L = (long)i * G + c; if (L >= nwg) return false;
        wgid = (int)L; { const int q = nwg / NXCD, r = nwg % NXCD, xcd = wgid % NXCD, off = wgid / NXCD; wgid = (xcd < r ? xcd * (q + 1) : r * (q + 1) + (xcd - r) * q) + off; }
        }
        const int nig = WGM * nN, gid = wgid / nig, fm = gid * WGM, gsz = (nM - fm) < WGM ? (nM - fm) : WGM;
        u.pm = fm + ((wgid % nig) % gsz); u.pn = (wgid % nig) / gsz; u.idx = i; return true;
    }
};

template <class Epi, bool RP = false, bool TS = false>
__device__ __forceinline__ void gemm_phase(LAS unsigned char* lds, const Gemm g, const StaticOrder& S, const Epi& E) {
    int tid = threadIdx.x; asm volatile("" : "+v"(tid));
    const int wid = __builtin_amdgcn_readfirstlane(tid >> 6), lane = tid & 63, wr = wid >> 2, wc = wid & 3, fr = lane & 15, fq = lane >> 4;
    const int K = g.K, nt = K / BK;
    unsigned voffA[2], voffB[2];
#pragma unroll
    for (int i = 0; i < 2; ++i) { int R, C; stage_rc(tid * 16 + i * 8192, R, C); const int Rb = (R & ~31) + perm32(R & 31); const int Ra = RP ? (128 * (R >> 6) + (R & 63)) : R;
        voffA[i] = (unsigned)(Ra * K + C) * 2u; voffB[i] = (unsigned)(Rb * K + C) * 2u; }
    const size_t kstep = (size_t)(BK * 2);
    const size_t hstep = (size_t)HALF * K * 2;
    const size_t tstep = 2 * hstep;
    const size_t hstepA = RP ? (size_t)64 * K * 2 : hstep;
    const unsigned ldsw = (unsigned)wid * 1024u;
    const int aoff = lds_byte(wr * 64 + fr, fq * 8), boff = lds_byte(wc * 32 + fr, fq * 8);
#define PG8_SA(b, h) (((b) * 2 + (h)) * HTB)
#define PG8_SB(b, h) ((4 + (b) * 2 + (h)) * HTB)
#define PG8_STAGE(bufoff, gbase, voff) do { _Pragma("unroll") for (int _i = 0; _i < 2; ++_i) \
        __builtin_amdgcn_global_load_lds((const unsigned*)((const char*)(gbase) + (voff)[_i]), (LAS unsigned*)(lds + (bufoff) + ldsw + _i * 8192), 16, 0, 0); } while (0)
#define PG8_LDA(dst, b, h) do { _Pragma("unroll") for (int m = 0; m < 4; ++m) _Pragma("unroll") for (int k = 0; k < 2; ++k) dst[m][k] = *(const LAS bf16x8*)(lds + PG8_SA(b, h) + aoff + m * 2048 + k * 1024); } while (0)
#define PG8_LDB(dst, b, h) do { _Pragma("unroll") for (int n = 0; n < 2; ++n) _Pragma("unroll") for (int k = 0; k < 2; ++k) dst[n][k] = *(const LAS bf16x8*)(lds + PG8_SB(b, h) + boff + n * 2048 + k * 1024); } while (0)
#define PG8_MMA(ai, bj, At, Bt) do { __builtin_amdgcn_s_setprio(1); _Pragma("unroll") for (int m = 0; m < 4; ++m) _Pragma("unroll") for (int n = 0; n < 2; ++n) _Pragma("unroll") for (int k = 0; k < 2; ++k) \
        acc[ai][bj][m][n] = __builtin_amdgcn_mfma_f32_16x16x32_bf16(Bt[n][k], At[m][k], acc[ai][bj][m][n], 0, 0, 0); __builtin_amdgcn_s_setprio(0); } while (0)
#define PG8_WAIT_V(n) asm volatile("s_waitcnt vmcnt(" #n ")" ::: "memory")
#define PG8_WAIT_L(n) asm volatile("s_waitcnt lgkmcnt(" #n ")" ::: "memory")
#define PG8_BAR __builtin_amdgcn_s_barrier()
#define PG8_SCHED __builtin_amdgcn_sched_barrier(0)
    Unit cur, nxt; int ui = 0;
    if (!S.next(0, cur)) return;
    f32x4 acc[2][2][4][2];
#pragma unroll
    for (int a = 0; a < 2; ++a)
#pragma unroll
        for (int b = 0; b < 2; ++b)
#pragma unroll
            for (int m = 0; m < 4; ++m)
#pragma unroll
                for (int n = 0; n < 2; ++n) acc[a][b][m][n] = (f32x4){0.f, 0.f, 0.f, 0.f};
    bf16x8 At[4][2], B0[2][2], B1[2][2];
    const char* cA = (const char*)g.A + (size_t)cur.pm * tstep + (size_t)cur.pn * g.a_pn_stride; const char* cB = (const char*)g.Bt + (size_t)cur.pn * tstep + ((TS && cur.half == 1) ? hstep : 0);
    bool fullc = !(TS && cur.half >= 0);
    PG8_STAGE(PG8_SB(0, 0), cB, voffB); PG8_STAGE(PG8_SB(0, 1), cB + hstep, voffB); PG8_STAGE(PG8_SA(0, 0), cA, voffA); PG8_STAGE(PG8_SA(0, 1), cA + hstepA, voffA);
    if (wr == 1) PG8_BAR;
    PG8_WAIT_V(2); PG8_BAR;
    PG8_STAGE(PG8_SB(1, 0), cB + kstep, voffB); PG8_STAGE(PG8_SA(1, 0), cA + kstep, voffA); PG8_STAGE(PG8_SB(1, 1), cB + hstep + kstep, voffB);
    PG8_WAIT_V(6); PG8_BAR;
    for (;;) {
        const bool has_next = S.next(ui + 1, nxt);
        const char* nA = has_next ? (const char*)g.A + (size_t)nxt.pm * tstep + (size_t)nxt.pn * g.a_pn_stride : cA; const char* nB = has_next ? (const char*)g.Bt + (size_t)nxt.pn * tstep + ((TS && nxt.half == 1) ? hstep : 0) : cB;
        for (int t = 0; t < nt; t += 2) {
            const bool last = (t == nt - 2);
            const char* a1 = cA + (size_t)(t + 1) * kstep;
            const char* a2 = last ? nA : cA + (size_t)(t + 2) * kstep; const char* b2 = last ? nB : cB + (size_t)(t + 2) * kstep;
            const char* a3 = a2 + kstep; const char* b3 = b2 + kstep;
            PG8_LDB(B0, 0, 0); if (!TS || fullc) PG8_LDB(B1, 0, 1); PG8_SCHED; PG8_LDA(At, 0, 0); PG8_STAGE(PG8_SA(1, 1), a1 + hstepA, voffA);
            PG8_WAIT_V(8); PG8_WAIT_L(0); PG8_BAR; PG8_MMA(0, 0, At, B0); if (!TS || fullc) PG8_MMA(0, 1, At, B1); PG8_BAR; PG8_SCHED;
            PG8_LDA(At, 0, 1); PG8_STAGE(PG8_SB(0, 0), b2, voffB); PG8_STAGE(PG8_SB(0, 1), b2 + hstep, voffB); PG8_STAGE(PG8_SA(0, 0), a2, voffA);
            PG8_WAIT_V(8); PG8_WAIT_L(0); PG8_BAR; PG8_MMA(1, 0, At, B0); if (!TS || fullc) PG8_MMA(1, 1, At, B1); PG8_BAR; PG8_SCHED;
            PG8_LDB(B0, 1, 0); if (!TS || fullc) PG8_LDB(B1, 1, 1); PG8_SCHED; PG8_LDA(At, 1, 0); PG8_STAGE(PG8_SA(0, 1), a2 + hstepA, voffA);
            PG8_WAIT_V(8); PG8_WAIT_L(0); PG8_BAR; PG8_MMA(0, 0, At, B0); if (!TS || fullc) PG8_MMA(0, 1, At, B1); PG8_BAR; PG8_SCHED;
            PG8_LDA(At, 1, 1); PG8_STAGE(PG8_SB(1, 0), b3, voffB); PG8_STAGE(PG8_SB(1, 1), b3 + hstep, voffB); PG8_STAGE(PG8_SA(1, 0), a3, voffA);
            PG8_WAIT_V(8); PG8_WAIT_L(0); PG8_BAR; PG8_MMA(1, 0, At, B0); if (!TS || fullc) PG8_MMA(1, 1, At, B1); PG8_BAR; PG8_SCHED;
        }
        if (wr == 0) PG8_BAR;
        E(acc, cur, wr, wc, fr, fq);
        if (!has_next) break;
#pragma unroll
        for (int a = 0; a < 2; ++a)
#pragma unroll
            for (int b = 0; b < 2; ++b)
#pragma unroll
                for (int m = 0; m < 4; ++m)
#pragma unroll
                    for (int n = 0; n < 2; ++n) acc[a][b][m][n] = (f32x4){0.f, 0.f, 0.f, 0.f};
        cur = nxt; cA = nA; cB = nB; ++ui; fullc = !(TS && cur.half >= 0);
        if (wr == 1) PG8_BAR;
    }
    PG8_WAIT_V(0);
    PG8_BAR;
#undef PG8_SA
#undef PG8_SB
#undef PG8_STAGE
#undef PG8_LDA
#undef PG8_LDB
#undef PG8_MMA
#undef PG8_WAIT_V
#undef PG8_WAIT_L
#undef PG8_BAR
#undef PG8_SCHED
}

typedef f32x4 Acc[2][2][4][2];

template <int CTRL> __device__ __forceinline__ float dppz(float v) { return __builtin_bit_cast(float, __builtin_amdgcn_update_dpp(0, __builtin_bit_cast(int, v), CTRL, 0xf, 0xf, true)); }
__device__ __forceinline__ float scan_up(float v) { v += dppz<0x111>(v); v += dppz<0x112>(v); v += dppz<0x114>(v); v += dppz<0x118>(v); return v; }
__device__ __forceinline__ float scan_dn(float v) { v += dppz<0x101>(v); v += dppz<0x102>(v); v += dppz<0x104>(v); v += dppz<0x108>(v); return v; }

struct EpiEven {
    bf16_t* OUT; bf16_t* CUS; bf16_t* GZS; bf16_t* U0; bf16_t* Z0; bf16_t* UT; const float* conv_w;
    template <int W> __device__ __forceinline__ void pooled(const Acc& acc, const Unit& u, int wr, int wc, int fr, int fq) const {
        const int chl = 128 * u.pn + 32 * wc + 8 * fq;
        const int blk = u.pm * 2 + wr;
        const size_t rowb = (size_t)u.pm * BM + wr * 128 + fr;
        float qprev[8];
#pragma unroll
        for (int e = 0; e < 8; ++e) qprev[e] = 0.f;
#pragma unroll
        for (int g8 = 0; g8 < 8; ++g8) { const int ai = g8 >> 2, m = g8 & 3;
            float uu[8], zz[8], o[8];
#pragma unroll
            for (int n = 0; n < 2; ++n)
#pragma unroll
                for (int j = 0; j < 4; ++j) { uu[4 * n + j] = acc[ai][0][m][n][j]; zz[4 * n + j] = silu_f(acc[ai][1][m][n][j]); }
#pragma unroll
            for (int e = 0; e < 8; ++e) {
                float cur = uu[e], q = uu[e];
                if constexpr (W >= 2)  { cur += dppz<0x111>(cur); q += dppz<0x101>(q); }
                if constexpr (W >= 4)  { cur += dppz<0x112>(cur); q += dppz<0x102>(q); }
                if constexpr (W >= 8)  { cur += dppz<0x114>(cur); q += dppz<0x104>(q); }
                if constexpr (W >= 16) { cur += dppz<0x118>(cur); q += dppz<0x108>(q); }
                const float prv = dppz<0x100 + ((17 - W) & 15)>(qprev[e]);
                o[e] = ((cur + prv) * (1.0f / W) - uu[e]) * zz[e]; qprev[e] = q; }
            const size_t row = rowb + ai * 64 + m * 16;
            if (!(g8 == 0 && fr < 15)) *(u32x4*)(OUT + row * EVEN_W + chl) = pack8v(o);
            if (g8 == 0 && fr < 15) { *(u32x4*)(U0 + ((size_t)blk * 15 + fr) * 1024 + chl) = pack8v(uu); *(u32x4*)(Z0 + ((size_t)blk * 15 + fr) * 1024 + chl) = pack8v(zz); }
            if (g8 == 7 && fr >= 1) *(u32x4*)(UT + ((size_t)blk * 15 + fr - 1) * 1024 + chl) = pack8v(uu);
        }
    }
    __device__ __forceinline__ void operator()(const Acc& acc, const Unit& u, int wr, int wc, int fr, int fq) const {
        const int pn = u.pn;
        if (pn < 8) {
            switch (pn >> 1) { case 0: pooled<2>(acc, u, wr, wc, fr, fq); break; case 1: pooled<4>(acc, u, wr, wc, fr, fq); break;
                               case 2: pooled<8>(acc, u, wr, wc, fr, fq); break; default: pooled<16>(acc, u, wr, wc, fr, fq); break; }
        } else {
            const int row0 = u.pm * BM + wr * 128 + fr;
            const int ch0 = 64 * (pn - 8) + 16 * wc + 4 * fq;
            const f32x4 cw0 = *(const f32x4*)(conv_w + ch0), cw1 = *(const f32x4*)(conv_w + 1024 + ch0), cw2 = *(const f32x4*)(conv_w + 2048 + ch0);
#pragma unroll
            for (int ai = 0; ai < 2; ++ai) {
                const int grp = u.pm * 4 + wr * 2 + ai;
                f32x4 cup = (f32x4){0.f, 0.f, 0.f, 0.f};
#pragma unroll
                for (int m = 0; m < 4; ++m) {
                    const f32x4 cu = acc[ai][0][m][0] * acc[ai][0][m][1];
                    f32x4 gz = acc[ai][1][m][1];
#pragma unroll
                    for (int j = 0; j < 4; ++j) gz[j] = silu_f(gz[j]);
                    gz = gz * acc[ai][1][m][0];
                    f32x4 o;
#pragma unroll
                    for (int j = 0; j < 4; ++j) {
                        const float q1 = dppz<0x111>(cu[j]) + dppz<0x10F>(cup[j]);
                        const float q2 = dppz<0x112>(cu[j]) + dppz<0x10E>(cup[j]);
                        o[j] = gz[j] * (cw2[j] * cu[j] + cw1[j] * q1 + cw0[j] * q2); }
                    cup = cu;
                    const size_t row = (size_t)(row0 + ai * 64 + m * 16);
                    u32x2 w; w.x = cvt_pk_bf16(o[0], o[1]); w.y = cvt_pk_bf16(o[2], o[3]);
                    if (!(m == 0 && fr < 2)) *(u32x2*)(OUT + row * EVEN_W + 1024 + ch0) = w;
                    if (m == 0 && fr < 2) { u32x2 c2; c2.x = cvt_pk_bf16(cu[0], cu[1]); c2.y = cvt_pk_bf16(cu[2], cu[3]); u32x2 g2; g2.x = cvt_pk_bf16(gz[0], gz[1]); g2.y = cvt_pk_bf16(gz[2], gz[3]);
                        *(u32x2*)(CUS + (size_t)(grp * 4 + fr) * 1024 + ch0) = c2; *(u32x2*)(GZS + (size_t)(grp * 2 + fr) * 1024 + ch0) = g2; }
                    if (m == 3 && fr >= 14) { u32x2 c2; c2.x = cvt_pk_bf16(cu[0], cu[1]); c2.y = cvt_pk_bf16(cu[2], cu[3]);
                        *(u32x2*)(CUS + (size_t)(grp * 4 + 2 + (fr - 14)) * 1024 + ch0) = c2; }
                }
            }
        }
    }
};

struct EpiRes1 {
    bf16_t* h1b; const float* rs0  ; const float* g0; float* ss;
    __device__ __forceinline__ void operator()(const Acc& acc, const Unit& u, int wr, int wc, int fr, int fq) const {
        const int row0 = u.pm * BM + wr * 64 + fr, col0 = u.pn * BM + wc * 32 + 8 * fq;
        f32x4 ig[2][2]; float rs[2][4];
#pragma unroll
        for (int bj = 0; bj < 2; ++bj)
#pragma unroll
            for (int n = 0; n < 2; ++n) { const f32x4 g = *(const f32x4*)(g0 + col0 + bj * HALF + 4 * n); ig[bj][n] = (f32x4){1.0f / g[0], 1.0f / g[1], 1.0f / g[2], 1.0f / g[3]}; }
#pragma unroll
        for (int ai = 0; ai < 2; ++ai)
#pragma unroll
            for (int m = 0; m < 4; ++m) rs[ai][m] = rs0[row0 + ai * HALF + m * 16];
#pragma unroll
        for (int ai = 0; ai < 2; ++ai)
#pragma unroll
            for (int m = 0; m < 4; ++m) { const size_t row = (size_t)(row0 + ai * HALF + m * 16); float sq = 0.f; const float r_ = rs[ai][m];
#pragma unroll
                for (int bj = 0; bj < 2; ++bj) { const size_t off = row * D + col0 + bj * HALF;
                    const u32x4 h = *(const u32x4*)(h1b + off);
                    const f32x4 x0 = (f32x4){bf_lo(h.x), bf_hi(h.x), bf_lo(h.y), bf_hi(h.y)} * r_ * ig[bj][0], x1 = (f32x4){bf_lo(h.z), bf_hi(h.z), bf_lo(h.w), bf_hi(h.w)} * r_ * ig[bj][1];
                    const f32x4 v0 = acc[ai][bj][m][0] + x0, v1 = acc[ai][bj][m][1] + x1;
                    sq += (v0[0] * v0[0] + v0[1] * v0[1]) + (v0[2] * v0[2] + v0[3] * v0[3]) + (v1[0] * v1[0] + v1[1] * v1[1]) + (v1[2] * v1[2] + v1[3] * v1[3]);
                    u32x4 w; w.x = cvt_pk_bf16(v0[0], v0[1]); w.y = cvt_pk_bf16(v0[2], v0[3]); w.z = cvt_pk_bf16(v1[0], v1[1]); w.w = cvt_pk_bf16(v1[2], v1[3]);
                    *(u32x4*)(h1b + off) = w; }
                sq += __shfl_xor(sq, 16); sq += __shfl_xor(sq, 32);
                if (fq == 0) ss[row * 16 + u.pn * 4 + wc] = sq; }
    }
};
struct EpiFinal {
    const bf16_t* h1b; float* out; const float* bias; const float* gF; float* slots; unsigned* cnt; LAS unsigned char* xl;
    __device__ __forceinline__ void operator()(Acc& acc, const Unit& u, int wr, int wc, int fr, int fq) const {
        LAS float* P = (LAS float*)xl;
        LAS float* S = (LAS float*)(xl + 4096);
        int tid = threadIdx.x; asm volatile("" : "+v"(tid));
        const int lane = tid & 63, wid = __builtin_amdgcn_readfirstlane(tid >> 6);
        const int row0 = u.pm * BM + wr * 64 + fr, col0 = u.pn * BM + wc * 32 + 8 * fq;
        f32x4 bv[2][2];
#pragma unroll
        for (int bj = 0; bj < 2; ++bj)
#pragma unroll
            for (int n = 0; n < 2; ++n) bv[bj][n] = *(const f32x4*)(bias + col0 + bj * HALF + 4 * n);
#pragma unroll
        for (int ai = 0; ai < 2; ++ai)
#pragma unroll
            for (int m = 0; m < 4; ++m) { const size_t row = (size_t)(row0 + ai * HALF + m * 16); float sq = 0.f;
#pragma unroll
                for (int bj = 0; bj < 2; ++bj) { const u32x4 h = *(const u32x4*)(h1b + row * D + col0 + bj * HALF);
                    const f32x4 r0 = (f32x4){bf_lo(h.x), bf_hi(h.x), bf_lo(h.y), bf_hi(h.y)}, r1 = (f32x4){bf_lo(h.z), bf_hi(h.z), bf_lo(h.w), bf_hi(h.w)};
                    const f32x4 v0 = acc[ai][bj][m][0] + bv[bj][0] + r0, v1 = acc[ai][bj][m][1] + bv[bj][1] + r1;
                    acc[ai][bj][m][0] = v0; acc[ai][bj][m][1] = v1;
                    sq += (v0[0] * v0[0] + v0[1] * v0[1]) + (v0[2] * v0[2] + v0[3] * v0[3]) + (v1[0] * v1[0] + v1[1] * v1[1]) + (v1[2] * v1[2] + v1[3] * v1[3]); }
                sq += __shfl_xor(sq, 16); sq += __shfl_xor(sq, 32);
                if (fq == 0) P[(ai * HALF + wr * 64 + m * 16 + fr) * 4 + wc] = sq; }
        asm volatile("s_waitcnt lgkmcnt(0)" ::: "memory"); __builtin_amdgcn_s_barrier(); asm volatile("" ::: "memory");
        if (tid < 256) { const float t_ = (P[tid * 4 + 0] + P[tid * 4 + 1]) + (P[tid * 4 + 2] + P[tid * 4 + 3]);
            __hip_atomic_store(slots + ((size_t)(u.pm * BM + tid) * 4 + u.pn), t_, __ATOMIC_RELAXED, __HIP_MEMORY_SCOPE_AGENT); }
        asm volatile("s_waitcnt vmcnt(0)" ::: "memory");
        if (lane == 0 && wid < 4) __hip_atomic_fetch_add(cnt + 16 * u.pm, 1u, __ATOMIC_RELAXED, __HIP_MEMORY_SCOPE_AGENT);
        if (wid == 0) { unsigned sp = 0;
            while ((unsigned)__builtin_amdgcn_readfirstlane((int)__hip_atomic_load(cnt + 16 * u.pm, __ATOMIC_RELAXED, __HIP_MEMORY_SCOPE_AGENT)) < 16u) { __builtin_amdgcn_s_sleep(1); if (++sp > (1u << 22)) break; }
            __builtin_amdgcn_fence(__ATOMIC_ACQUIRE, "agent"); }
        asm volatile("s_waitcnt vmcnt(0) lgkmcnt(0)" ::: "memory"); __builtin_amdgcn_s_barrier(); asm volatile("" ::: "memory");
        if (tid < 256) { const float* sl = slots + (size_t)(u.pm * BM + tid) * 4; float t_ = 0.f;
#pragma unroll
            for (int k = 0; k < 4; ++k) t_ += __hip_atomic_load(sl + k, __ATOMIC_RELAXED, __HIP_MEMORY_SCOPE_AGENT);
            S[tid] = rsqrtf(t_ * (1.0f / D) + EPS); }
        asm volatile("s_waitcnt lgkmcnt(0)" ::: "memory"); __builtin_amdgcn_s_barrier(); asm volatile("" ::: "memory");
        f32x4 gv[2][2];
#pragma unroll
        for (int bj = 0; bj < 2; ++bj)
#pragma unroll
            for (int n = 0; n < 2; ++n) gv[bj][n] = *(const f32x4*)(gF + col0 + bj * HALF + 4 * n);
#pragma unroll
        for (int ai = 0; ai < 2; ++ai)
#pragma unroll
            for (int m = 0; m < 4; ++m) { const size_t row = (size_t)(row0 + ai * HALF + m * 16); const float rs = S[ai * HALF + wr * 64 + m * 16 + fr];
#pragma unroll
                for (int bj = 0; bj < 2; ++bj) { float* op = out + row * D + col0 + bj * HALF;
                    *(f32x4*)op = acc[ai][bj][m][0] * rs * gv[bj][0]; *(f32x4*)(op + 4) = acc[ai][bj][m][1] * rs * gv[bj][1]; } }
    }
};

struct EpiQKVZ {
    bf16_t* O; const float* bias; const float* cosT; const float* sinT; const LAS float* rstd_lds;
    __device__ __forceinline__ void operator()(const Acc& acc, const Unit& u, int wr, int wc, int fr, int fq) const {
        const int row0 = u.pm * BM + wr * 64 + fr, col0 = u.pn * BM + wc * 32 + 8 * fq;
        const int pn = u.pn;
        const bool halfu = u.half >= 0;
        f32x4 bv[2][2];
#pragma unroll
        for (int bj = 0; bj < 2; ++bj)
#pragma unroll
            for (int n = 0; n < 2; ++n) bv[bj][n] = *(const f32x4*)(bias + col0 + (halfu ? u.half : bj) * HALF + 4 * n);
        const bool rot_wave = ((wc & 1) == 0) && (pn <= 4);
        const LAS float* rl = rstd_lds + u.idx * 256 + wr * 64 + fr;
#pragma unroll
        for (int ai = 0; ai < 2; ++ai)
#pragma unroll
            for (int m = 0; m < 4; ++m) { const size_t row = (size_t)(row0 + ai * HALF + m * 16);
                const float rstd = rl[ai * HALF + m * 16];
                f32x4 cs[2], sn[2];
                if (rot_wave) { cs[0] = *(const f32x4*)(cosT + row * 8); cs[1] = *(const f32x4*)(cosT + row * 8 + 4); sn[0] = *(const f32x4*)(sinT + row * 8); sn[1] = *(const f32x4*)(sinT + row * 8 + 4); }
                else { cs[0] = cs[1] = sn[0] = sn[1] = (f32x4){0.f, 0.f, 0.f, 0.f}; }
#pragma unroll
                for (int bj = 0; bj < 2; ++bj) {
                    if (halfu && bj == 1) continue;
                    const int cb = halfu ? u.half : bj;
                    f32x4 v[2];
                    v[0] = acc[ai][bj][m][0] * rstd + bv[bj][0]; v[1] = acc[ai][bj][m][1] * rstd + bv[bj][1];
                    const bool is_q = pn < 4, is_k = (pn == 4 && cb == 0), is_z = pn > 4;
                    if (rot_wave && (is_q || is_k)) {
#pragma unroll
                        for (int n = 0; n < 2; ++n)
#pragma unroll
                            for (int j = 0; j < 4; ++j) { const float x = v[n][j]; const float p = __shfl_xor(x, 16);
                                const float r0 = x * cs[n][j] - p * sn[n][j], r1 = x * cs[n][j] + p * sn[n][j];
                                v[n][j] = (fq == 0) ? r0 : ((fq == 1) ? r1 : x); }
                    }
                    if (is_q) { v[0] = v[0] * C2; v[1] = v[1] * C2; }
                    if (is_z) {
#pragma unroll
                        for (int n = 0; n < 2; ++n)
#pragma unroll
                            for (int j = 0; j < 4; ++j) v[n][j] = silu_f(v[n][j]); }
                    u32x4 w; w.x = cvt_pk_bf16(v[0][0], v[0][1]); w.y = cvt_pk_bf16(v[0][2], v[0][3]); w.z = cvt_pk_bf16(v[1][0], v[1][1]); w.w = cvt_pk_bf16(v[1][2], v[1][3]);
                    __builtin_nontemporal_store(w, (u32x4*)(O + row * ODD_IN + col0 + cb * HALF)); } }
    }
};
}

__device__ __forceinline__ float wave_sum(float v) {
#pragma unroll
    for (int o = 1; o < 64; o <<= 1) v += __shfl_xor(v, o);
    return v;
}
__device__ __forceinline__ int even_dst_row(int s);
__device__ __forceinline__ void p0_transpose_item(const float* W, int K, int N, bf16_t* WT, int row_off, LAS float* scr, int k0, int n0, int lane, const float* kscale = nullptr, bool evenmap = false) {
#pragma unroll
    for (int i = 0; i < 32; ++i) { const int kk = 2 * i + (lane >> 5); float wv = __builtin_nontemporal_load(W + (size_t)(k0 + kk) * N + n0 + (lane & 31)); if (kscale) wv *= kscale[k0 + kk]; scr[kk * 33 + (lane & 31)] = wv; }
    asm volatile("s_waitcnt lgkmcnt(0)" ::: "memory");
    const int c = lane & 7;
#pragma unroll
    for (int j = 0; j < 4; ++j) { const int n = (lane >> 3) + 8 * j; const LAS float* s = scr + (8 * c) * 33 + n;
        u32x4 o; o.x = cvt_pk_bf16(s[0 * 33], s[1 * 33]); o.y = cvt_pk_bf16(s[2 * 33], s[3 * 33]); o.z = cvt_pk_bf16(s[4 * 33], s[5 * 33]); o.w = cvt_pk_bf16(s[6 * 33], s[7 * 33]);
        const int drow = evenmap ? even_dst_row(n0 + n) : row_off + n0 + n;
        *(u32x4*)(WT + (size_t)drow * K + k0 + 8 * c) = o; }
    asm volatile("s_waitcnt lgkmcnt(0)" ::: "memory");
}

__device__ __forceinline__ void p0_fold_item(const float* Win, const float* Wp, const float* ps, bf16_t* WT1, int item, int lane) {
    const int dt = item & 7, kt = (item >> 3) & 31, g = item >> 8;
    const int r32 = lane & 31, hi = lane >> 5, k0 = kt * 32, d0 = dt * 32;
    const float* ap = Win + (size_t)(k0 + r32) * EVEN_IN + g * 256 + 16 * hi;
    const float* bp = Wp + (size_t)g * 65536 + (size_t)(16 * hi) * 256 + d0 + r32;
    f32x16 acc;
#pragma unroll
    for (int r = 0; r < 16; ++r) acc[r] = 0.f;
    f32x4 a4[2][4]; float b[2][16];
#pragma unroll
    for (int q = 0; q < 4; ++q) a4[0][q] = *(const f32x4*)(ap + 4 * q);
#pragma unroll
    for (int j = 0; j < 16; ++j) b[0][j] = bp[(size_t)j * 256];
#pragma unroll
    for (int ci = 0; ci < 8; ++ci) { const int cb = ci & 1, nb = cb ^ 1, base = 32 * (ci + 1);
        if (ci < 7) {
#pragma unroll
            for (int q = 0; q < 4; ++q) a4[nb][q] = *(const f32x4*)(ap + base + 4 * q);
#pragma unroll
            for (int j = 0; j < 16; ++j) b[nb][j] = bp[(size_t)(base + j) * 256]; }
#pragma unroll
        for (int j = 0; j < 16; ++j) acc = __builtin_amdgcn_mfma_f32_32x32x2f32(a4[cb][j >> 2][j & 3], b[cb][j], acc, 0, 0, 0);
    }
    const float sc = ps[g * 256 + d0 + r32];
    const int uc = g * 256 + d0 + r32;
    bf16_t* op = WT1 + (size_t)((uc >> 7) * 256 + (uc & 127)) * D + k0 + 4 * hi;
#pragma unroll
    for (int q = 0; q < 4; ++q) { u32x2 o; o.x = cvt_pk_bf16(acc[4 * q + 0] * sc, acc[4 * q + 1] * sc); o.y = cvt_pk_bf16(acc[4 * q + 2] * sc, acc[4 * q + 3] * sc); *(u32x2*)(op + 8 * q) = o; }
}
__device__ __forceinline__ int even_dst_row(int s) {
    const int seg = s >> 10, ch = s & 1023;
    if (seg == 4) return (ch >> 7) * 256 + 128 + (ch & 127);
    const int q = (seg == 2) ? 0 : (seg == 3) ? 1 : (seg == 1) ? 2 : 3;
    return (8 + (ch >> 6)) * 256 + 128 * (q >> 1) + 32 * ((ch >> 4) & 3) + 8 * ((ch >> 2) & 3) + 4 * (q & 1) + (ch & 3);
}
__device__ const float INVF[8] = {1.0f, 0.19392274474868576f, 0.03760603093086393f, 0.007292664737217109f, 0.001414213562373095f, 0.0002742481756762073f, 5.318295896944988e-05f, 1.031338537721246e-05f};

struct Args { const void* in[14]; float* out; unsigned char* ws; int ph_lo, ph_hi, rep_mask, pad; };

__device__ __forceinline__ void unpack8(const u32x4 w, float (&f)[8]) {
    f[0] = bf_lo(w.x); f[1] = bf_hi(w.x); f[2] = bf_lo(w.y); f[3] = bf_hi(w.y); f[4] = bf_lo(w.z); f[5] = bf_hi(w.z); f[6] = bf_lo(w.w); f[7] = bf_hi(w.w);
}
__device__ __forceinline__ u32x4 pack8(const float (&f)[8]) {
    u32x4 w; w.x = cvt_pk_bf16(f[0], f[1]); w.y = cvt_pk_bf16(f[2], f[3]); w.z = cvt_pk_bf16(f[4], f[5]); w.w = cvt_pk_bf16(f[6], f[7]); return w;
}
constexpr int RUN = 32, NRUN = M / RUN, NCH = 128;
template <int W> __device__ __forceinline__ void p2_pool_item(bf16_t* OUT, const bf16_t* U0, const bf16_t* Z0, const bf16_t* UT, int blk, int c0) {
    const bool first = ((blk * 128) % SEQ) == 0;
    const bf16_t* u0 = U0 + (size_t)blk * 15 * 1024 + c0; const bf16_t* z0 = Z0 + (size_t)blk * 15 * 1024 + c0;
    const bf16_t* ut = UT + ((size_t)blk * 15 - 15) * 1024 + c0;
    u32x4 lu[15], lz[5], lt[W - 1];
#pragma unroll
    for (int t = 0; t < 15; ++t) lu[t] = __builtin_nontemporal_load((const u32x4*)(u0 + (size_t)t * 1024));
#pragma unroll
    for (int k = 1; k < W; ++k) lt[k - 1] = first ? (u32x4){0u, 0u, 0u, 0u} : __builtin_nontemporal_load((const u32x4*)(ut + (size_t)(15 - k) * 1024));
    float sum[8];
#pragma unroll
    for (int e = 0; e < 8; ++e) sum[e] = 0.f;
#pragma unroll
    for (int k = 1; k < W; ++k) { float f[8]; unpack8(lt[k - 1], f);
#pragma unroll
        for (int e = 0; e < 8; ++e) sum[e] += f[e]; }
#pragma unroll
    for (int t = 0; t < 15; ++t) {
        if (t % 5 == 0) {
#pragma unroll
            for (int q = 0; q < 5; ++q) lz[q] = __builtin_nontemporal_load((const u32x4*)(z0 + (size_t)(t + q) * 1024)); }
        float cur[8], sz[8], o[8]; unpack8(lu[t], cur); unpack8(lz[t % 5], sz);
        const int cnt = first ? ((t + 1 < W) ? (t + 1) : W) : W; const float inv = 1.0f / (float)cnt;
#pragma unroll
        for (int e = 0; e < 8; ++e) { sum[e] += cur[e]; o[e] = (sum[e] * inv - cur[e]) * sz[e]; }
        *(u32x4*)(OUT + (size_t)(blk * 128 + t) * EVEN_W + c0) = pack8(o);
        const int idx = t - W + 1;
        float old[8];
        if (idx >= 0) unpack8(lu[idx >= 0 ? idx : 0], old); else unpack8(lt[(-idx - 1) < (W - 1) ? (-idx - 1) : 0], old);
#pragma unroll
        for (int e = 0; e < 8; ++e) sum[e] -= old[e];
    }
}
__device__ __forceinline__ void p2_phase(bf16_t* OUT, const bf16_t* CUS, const bf16_t* GZS, const bf16_t* U0, const bf16_t* Z0, const bf16_t* UT, const float* conv_w, int gtid, int gthreads) {
    for (int it = gtid; it < (M / 128) * NCH; it += gthreads) {
        const int blk = it / NCH, chunk = it % NCH, c0 = chunk * 8;
        switch (chunk >> 5) { case 0: p2_pool_item<2>(OUT, U0, Z0, UT, blk, c0); break; case 1: p2_pool_item<4>(OUT, U0, Z0, UT, blk, c0); break;
                              case 2: p2_pool_item<8>(OUT, U0, Z0, UT, blk, c0); break; default: p2_pool_item<16>(OUT, U0, Z0, UT, blk, c0); break; }
    }
    for (int it = gtid; it < (M / 64) * NCH; it += gthreads) {
        const int grp = it / NCH, c0 = (it % NCH) * 8; const bool first = ((grp * 64) % SEQ) == 0;
        float cw0[8], cw1[8], cw2[8], cu0[8], cu1[8], pm1[8], pm2[8], gz0[8], gz1[8], o0[8], o1[8];
#pragma unroll
        for (int e = 0; e < 8; ++e) { cw0[e] = conv_w[c0 + e]; cw1[e] = conv_w[1024 + c0 + e]; cw2[e] = conv_w[2048 + c0 + e]; pm1[e] = 0.f; pm2[e] = 0.f; }
        unpack8(__builtin_nontemporal_load((const u32x4*)(CUS + (size_t)(grp * 4 + 0) * 1024 + c0)), cu0); unpack8(__builtin_nontemporal_load((const u32x4*)(CUS + (size_t)(grp * 4 + 1) * 1024 + c0)), cu1);
        unpack8(__builtin_nontemporal_load((const u32x4*)(GZS + (size_t)(grp * 2 + 0) * 1024 + c0)), gz0); unpack8(__builtin_nontemporal_load((const u32x4*)(GZS + (size_t)(grp * 2 + 1) * 1024 + c0)), gz1);
        if (!first) { unpack8(__builtin_nontemporal_load((const u32x4*)(CUS + (size_t)((grp - 1) * 4 + 3) * 1024 + c0)), pm1); unpack8(__builtin_nontemporal_load((const u32x4*)(CUS + (size_t)((grp - 1) * 4 + 2) * 1024 + c0)), pm2); }
#pragma unroll
        for (int e = 0; e < 8; ++e) { o0[e] = gz0[e] * (cw2[e] * cu0[e] + cw1[e] * pm1[e] + cw0[e] * pm2[e]); o1[e] = gz1[e] * (cw2[e] * cu1[e] + cw1[e] * cu0[e] + cw0[e] * pm1[e]); }
        *(u32x4*)(OUT + (size_t)(grp * 64) * EVEN_W + 1024 + c0) = pack8(o0); *(u32x4*)(OUT + (size_t)(grp * 64 + 1) * EVEN_W + 1024 + c0) = pack8(o1);
    }
}

__device__ __forceinline__ int crow(int r, int hi) { return (r & 3) + 8 * (r >> 2) + 4 * hi; }
constexpr int KS_STRIDE = 72, VT_STRIDE = 260, VT_OFF = 256 * KS_STRIDE * 2, ATT_WB_OFF = 70656;
static_assert(VT_OFF + 64 * VT_STRIDE * 2 <= ATT_WB_OFF && ATT_WB_OFF + 8 * 32 * KS_STRIDE * 2 <= 131072, "attention LDS map");
__device__ __forceinline__ void attn_phase(LAS unsigned char* lds, const bf16_t* P1, bf16_t* ATT, const float* sinks, int vcu, int G) {
    int tid = threadIdx.x; asm volatile("" : "+v"(tid));
    const int lane = tid & 63, wid = __builtin_amdgcn_readfirstlane(tid >> 6), r32 = lane & 31, hi = lane >> 5;
    LAS bf16_t* Ks = (LAS bf16_t*)lds;
    LAS bf16_t* Vt = (LAS bf16_t*)(lds + VT_OFF);
    LAS bf16_t* wb = (LAS bf16_t*)(lds + ATT_WB_OFF) + wid * (32 * KS_STRIDE);
    const int crow_ = lane >> 3, cpc = (lane & 7) * 8;
    constexpr int NU = (M / 128) * 2;
    u32x4 kvr[4], vvr[4];
#define ATT_LOAD_KV(unit_) do { const int kh_ = (unit_) & 1, blk_ = (unit_) >> 1, n_ = blk_ & 63; const unsigned R0_ = (unsigned)blk_ * 128u; \
        _Pragma("unroll") for (int i = 0; i < 4; ++i) { const int p = tid + 512 * i, key = p >> 3, ch = p & 7; \
            kvr[i] = (u32x4){0u, 0u, 0u, 0u}; vvr[i] = (u32x4){0u, 0u, 0u, 0u}; \
            if ((n_ > 0) || (key >= 128)) { const bf16_t* rp = P1 + ((R0_ + (unsigned)key - 128u) * (unsigned)ODD_IN + (unsigned)(kh_ * 64 + ch * 8)); kvr[i] = __builtin_nontemporal_load((const u32x4*)(rp + 1024)); vvr[i] = __builtin_nontemporal_load((const u32x4*)(rp + 1152)); } } } while (0)
    int unit = vcu;
    if (unit < NU) ATT_LOAD_KV(unit);
    for (; unit < NU; unit += G) {
        const int kh = unit & 1, blk = unit >> 1, n = blk & 63;
        const unsigned R0 = (unsigned)blk * 128u;
        __syncthreads();
#pragma unroll
        for (int i = 0; i < 4; ++i) {
            const int p = tid + 512 * i, key = p >> 3, ch = p & 7;
            const u32x4 kv = kvr[i], vv = vvr[i];
            *(LAS u32x4*)(Ks + key * KS_STRIDE + ch * 8) = kv;
            LAS bf16_t* vp = Vt + (ch * 8) * VT_STRIDE + key;
            vp[0 * VT_STRIDE] = (bf16_t)(vv.x & 0xffffu); vp[1 * VT_STRIDE] = (bf16_t)(vv.x >> 16);
            vp[2 * VT_STRIDE] = (bf16_t)(vv.y & 0xffffu); vp[3 * VT_STRIDE] = (bf16_t)(vv.y >> 16);
            vp[4 * VT_STRIDE] = (bf16_t)(vv.z & 0xffffu); vp[5 * VT_STRIDE] = (bf16_t)(vv.z >> 16);
            vp[6 * VT_STRIDE] = (bf16_t)(vv.w & 0xffffu); vp[7 * VT_STRIDE] = (bf16_t)(vv.w >> 16);
        }
        __syncthreads();
        if (unit + G < NU) ATT_LOAD_KV(unit + G);
        const int h = kh * 8 + wid;
        const float sink2 = sinks[h] * LOG2E;
        u32x4 qn[4], gn[4];
#define ATT_LOAD_QG(c_) do { const unsigned tk_ = R0 + 32u * (unsigned)(c_) + (unsigned)crow_; const bf16_t* qp_ = P1 + (tk_ * (unsigned)ODD_IN + (unsigned)(h * 64 + cpc)); \
        _Pragma("unroll") for (int i = 0; i < 4; ++i) { qn[i] = __builtin_nontemporal_load((const u32x4*)(qp_ + (unsigned)(8 * i) * (unsigned)ODD_IN)); gn[i] = __builtin_nontemporal_load((const u32x4*)(qp_ + (unsigned)(8 * i) * (unsigned)ODD_IN + 1280)); } } while (0)
        ATT_LOAD_QG(0);
        for (int c = 0; c < 4; ++c) {
            bf16x8 qf[4]; u32x2 gz[2][4];
#pragma unroll
            for (int i = 0; i < 4; ++i) *(LAS u32x4*)(wb + (crow_ + 8 * i) * KS_STRIDE + cpc) = qn[i];
#pragma unroll
            for (int d0 = 0; d0 < 4; ++d0) qf[d0] = *(const LAS bf16x8*)(wb + r32 * KS_STRIDE + d0 * 16 + hi * 8);
            asm volatile("s_waitcnt lgkmcnt(0)" ::: "memory");
#pragma unroll
            for (int i = 0; i < 4; ++i) *(LAS u32x4*)(wb + (crow_ + 8 * i) * KS_STRIDE + cpc) = gn[i];
#pragma unroll
            for (int dt = 0; dt < 2; ++dt)
#pragma unroll
                for (int g4 = 0; g4 < 4; ++g4) gz[dt][g4] = *(const LAS u32x2*)(wb + r32 * KS_STRIDE + 32 * dt + 8 * g4 + 4 * hi);
            asm volatile("s_waitcnt lgkmcnt(0)" ::: "memory");
            if (c < 3) ATT_LOAD_QG(c + 1);
            f32x16 st[5];
#pragma unroll
            for (int kt = 0; kt < 5; ++kt) {
                f32x16 a; const float a0 = ((n == 0) && (c + kt < 4)) ? -INFINITY : 0.f;
#pragma unroll
                for (int r = 0; r < 16; ++r) a[r] = a0;
#pragma unroll
                for (int d0 = 0; d0 < 4; ++d0) { const bf16x8 kf = *(const LAS bf16x8*)(Ks + (32 * (c + kt) + r32) * KS_STRIDE + d0 * 16 + hi * 8);
                    a = __builtin_amdgcn_mfma_f32_32x32x16_bf16(kf, qf[d0], a, 0, 0, 0); }
                st[kt] = a;
            }
            float mx = sink2;
#pragma unroll
            for (int kt = 0; kt < 5; ++kt)
#pragma unroll
                for (int r = 0; r < 16; ++r) { const int dd = 32 * kt + crow(r, hi) - r32;
                    float s_ = st[kt][r];
                    if (kt == 0) s_ = (dd >= 1) ? s_ : -INFINITY;
                    if (kt == 4) s_ = (dd <= 128) ? s_ : -INFINITY;
                    st[kt][r] = s_; mx = fmaxf(mx, s_); }
            { auto rr = __builtin_amdgcn_permlane32_swap(__float_as_uint(mx), __float_as_uint(mx), false, false); mx = fmaxf(__uint_as_float(rr[0]), __uint_as_float(rr[1])); }
            float l = 0.f;
#pragma unroll
            for (int kt = 0; kt < 5; ++kt)
#pragma unroll
                for (int r = 0; r < 16; ++r) { const float p = __builtin_amdgcn_exp2f(st[kt][r] - mx); st[kt][r] = p; l += p; }
            { auto rr = __builtin_amdgcn_permlane32_swap(__float_as_uint(l), __float_as_uint(l), false, false); l = __uint_as_float(rr[0]) + __uint_as_float(rr[1]); }
            l += __builtin_amdgcn_exp2f(sink2 - mx);
            f32x16 o[2];
#pragma unroll
            for (int r = 0; r < 16; ++r) { o[0][r] = 0.f; o[1][r] = 0.f; }
#pragma unroll
            for (int kt = 0; kt < 5; ++kt)
#pragma unroll
                for (int s_ = 0; s_ < 2; ++s_) {
                    u32x4 pw; pw.x = cvt_pk_bf16(st[kt][8 * s_ + 0], st[kt][8 * s_ + 1]); pw.y = cvt_pk_bf16(st[kt][8 * s_ + 2], st[kt][8 * s_ + 3]);
                    pw.z = cvt_pk_bf16(st[kt][8 * s_ + 4], st[kt][8 * s_ + 5]); pw.w = cvt_pk_bf16(st[kt][8 * s_ + 6], st[kt][8 * s_ + 7]);
                    const bf16x8 pf = __builtin_bit_cast(bf16x8, pw);
#pragma unroll
                    for (int dt = 0; dt < 2; ++dt) {
                        const LAS bf16_t* vp = Vt + (32 * dt + r32) * VT_STRIDE + 32 * (c + kt) + 16 * s_ + 4 * hi;
                        const s16x4 lo = *(const LAS s16x4*)vp, hi4 = *(const LAS s16x4*)(vp + 8);
                        const bf16x8 vf = (bf16x8){lo[0], lo[1], lo[2], lo[3], hi4[0], hi4[1], hi4[2], hi4[3]};
                        o[dt] = __builtin_amdgcn_mfma_f32_32x32x16_bf16(vf, pf, o[dt], 0, 0, 0);
                    }
                }
            const float rl = 1.0f / l;
#pragma unroll
            for (int dt = 0; dt < 2; ++dt)
#pragma unroll
                for (int g4 = 0; g4 < 4; ++g4) {
                    const u32x2 gzz = gz[dt][g4];
                    u32x2 w; w.x = cvt_pk_bf16(o[dt][4 * g4 + 0] * rl * bf_lo(gzz.x), o[dt][4 * g4 + 1] * rl * bf_hi(gzz.x));
                    w.y = cvt_pk_bf16(o[dt][4 * g4 + 2] * rl * bf_lo(gzz.y), o[dt][4 * g4 + 3] * rl * bf_hi(gzz.y));
                    *(LAS u32x2*)(wb + r32 * KS_STRIDE + 32 * dt + 8 * g4 + 4 * hi) = w;
                }
            asm volatile("s_waitcnt lgkmcnt(0)" ::: "memory");
            { bf16_t* op = ATT + ((R0 + 32u * (unsigned)c + (unsigned)crow_) * (unsigned)D + (unsigned)(h * 64 + cpc));
#pragma unroll
              for (int i = 0; i < 4; ++i) { const u32x4 v_ = *(const LAS u32x4*)(wb + (crow_ + 8 * i) * KS_STRIDE + cpc); *(u32x4*)(op + (unsigned)(8 * i) * (unsigned)D) = v_; } }
            asm volatile("s_waitcnt lgkmcnt(0)" ::: "memory");
        }
#undef ATT_LOAD_QG
    }
#undef ATT_LOAD_KV
}

#define XB_TMO      128
#define XB_XCNT(j)  (256  + 64 * (j))
#define XB_XSUB(j)  (1280 + 64 * (j))
#define XB_XGEN(j)  (2304 + 64 * (j))
#define XB_TOP      3328
#define XB_TOPGEN   3392
#define XCD_BAR_WORDS 3456
#define XB_SPIN_CAP (1u << 22)
__device__ __forceinline__ unsigned xb_ld(unsigned* p)              { return __hip_atomic_load(p, __ATOMIC_RELAXED, __HIP_MEMORY_SCOPE_AGENT); }
__device__ __forceinline__ unsigned xb_add(unsigned* p, unsigned v) { return __hip_atomic_fetch_add(p, v, __ATOMIC_RELAXED, __HIP_MEMORY_SCOPE_AGENT); }
__device__ __forceinline__ unsigned xb_xcc_id() { return (unsigned)__builtin_amdgcn_s_getreg((3 << 11) | 20) & 0xFu; }
#define XB_SPIN(cond, bar) do { unsigned _sp = 0; while (cond) { __builtin_amdgcn_s_sleep(1); \
    if ((++_sp & 255u) == 0u) { if (xb_ld(&(bar)[XB_TMO])) break; if (_sp > XB_SPIN_CAP) { atomicAdd(&(bar)[XB_TMO], 1u); break; } } } } while (0)
#define XB_EXIT     3400
__device__ unsigned g_barrier_words[XCD_BAR_WORDS];
__device__ unsigned g_panel_cnt[128 * 16];
struct XcdBarrier { unsigned* bar; unsigned x; volatile LAS unsigned* st; };
__device__ __forceinline__ XcdBarrier xcd_barrier_post(unsigned* bar, volatile LAS unsigned* st) {
    XcdBarrier b; b.bar = bar; b.x = xb_xcc_id(); b.st = st;
    if (threadIdx.x == 0) (void)xb_add(&bar[XB_XCNT(b.x)], 1u);
    return b;
}
__device__ __forceinline__ void xcd_barrier_complete(unsigned* bar, unsigned x, unsigned& nloc, unsigned& nx) {
    const unsigned G = gridDim.x * gridDim.y * gridDim.z;
    unsigned sum, cnt, mine, sp = 0u;
    for (;;) {
        sum = 0u; cnt = 0u; mine = 0u;
#pragma unroll
        for (unsigned j = 0; j < 16; ++j) { const unsigned c = xb_ld(&bar[XB_XCNT(j)]); sum += c; cnt += (c > 0u) ? 1u : 0u; mine = (j == x) ? c : mine; }
        if (sum == G) break;
        __builtin_amdgcn_s_sleep(1);
        if ((++sp & 255u) == 0u) { if (xb_ld(&bar[XB_TMO])) break; if (sp > XB_SPIN_CAP) { atomicAdd(&bar[XB_TMO], 1u); break; } }
    }
    nloc = mine > 0u ? mine : 1u; nx = cnt > 0u ? cnt : 1u;
}
__device__ __forceinline__ void xcd_barrier(const XcdBarrier& b) {
    asm volatile("s_waitcnt vmcnt(0)" ::: "memory");
    __syncthreads();
    if (threadIdx.x == 0) {
        unsigned* bar = b.bar;
        __builtin_amdgcn_s_waitcnt(0);
        unsigned nloc = b.st[0], nx = b.st[1];
        if (nloc == 0u) { xcd_barrier_complete(bar, b.x, nloc, nx); b.st[0] = nloc; b.st[1] = nx; }
        const unsigned old = xb_add(&bar[XB_XSUB(b.x)], 1u);
        const unsigned gen = old / nloc;
        if (old + 1u == (gen + 1u) * nloc) {
            __builtin_amdgcn_fence(__ATOMIC_RELEASE, "agent");
            asm volatile("s_waitcnt vmcnt(0)" ::: "memory");
            const unsigned og = xb_add(&bar[XB_TOP], 1u);
            const unsigned tg = og / nx;
            if (og + 1u == (tg + 1u) * nx) xb_add(&bar[XB_TOPGEN], 1u);
            else XB_SPIN(xb_ld(&bar[XB_TOPGEN]) == tg, bar);
            __builtin_amdgcn_fence(__ATOMIC_ACQUIRE, "agent");
            xb_add(&bar[XB_XGEN(b.x)], 1u);
            asm volatile("s_waitcnt vmcnt(0)" ::: "memory");
        } else {
            XB_SPIN(xb_ld(&bar[XB_XGEN(b.x)]) == gen, bar);
            __builtin_amdgcn_fence(__ATOMIC_ACQUIRE, "agent");
            asm volatile("s_waitcnt vmcnt(0)" ::: "memory");
        }
    }
    __syncthreads();
}

constexpr int RSTD_OFF = 131072 + 1024;
constexpr int LDS_BYTES = 131072 + 1024 + 5 * 256 * 4 + 64;
__global__ void __launch_bounds__(512, 2) fwd_megakernel(Args a) {
    __builtin_assume(__builtin_amdgcn_workitem_id_y() == 0); __builtin_assume(__builtin_amdgcn_workitem_id_z() == 0);
    extern __shared__ __attribute__((aligned(16))) unsigned char lds_raw[];
    LAS unsigned char* lds = (LAS unsigned char*)lds_raw;
    cg::grid_group grid = cg::this_grid();
#define FRESH_TID(tid, lane, wave) int tid = threadIdx.x; asm volatile("" : "+v"(tid)); const int lane = tid & 63, wave = __builtin_amdgcn_readfirstlane(tid >> 6); (void)lane; (void)wave
    const int G = gridDim.x, bx = blockIdx.x;
    const int vcu = (G % 8 == 0) ? (bx % 8) * (G / 8) + bx / 8 : bx;
    const float* x = (const float*)a.in[0]; const int* pos = (const int*)a.in[1]; const float* norm_g = (const float*)a.in[2];
    const float* w_in_even = (const float*)a.in[3]; const float* w_pool = (const float*)a.in[4]; const float* pool_scale = (const float*)a.in[5];
    const float* conv_w = (const float*)a.in[6]; const float* w_out_even = (const float*)a.in[7]; const float* w_in_odd = (const float*)a.in[8];
    const float* b_in_odd = (const float*)a.in[9]; const float* sinks = (const float*)a.in[10]; const float* w_out_odd = (const float*)a.in[11];
    const float* b_out_odd = (const float*)a.in[12]; const float* final_g = (const float*)a.in[13];
    unsigned char* ws = a.ws;
    float* SS1 = (float*)(ws + WS_SS1); float* SS2 = (float*)(ws + WS_SS2); float* COS = (float*)(ws + WS_COS);
    bf16_t* WT1 = (bf16_t*)(ws + WS_WT1); bf16_t* WT2 = (bf16_t*)(ws + WS_WT2); bf16_t* WT3 = (bf16_t*)(ws + WS_WT3); bf16_t* WT4 = (bf16_t*)(ws + WS_WT4);
    bf16_t* XN = (bf16_t*)(ws + WS_XN); bf16_t* PROJ1 = (bf16_t*)(ws + WS_PROJ1); bf16_t* ATT = (bf16_t*)(ws + WS_ATT); bf16_t* CUS = (bf16_t*)(ws + WS_CUS); bf16_t* GZS = (bf16_t*)(ws + WS_GZS); bf16_t* U0 = (bf16_t*)(ws + WS_U0); bf16_t* Z0 = (bf16_t*)(ws + WS_Z0); bf16_t* UT = (bf16_t*)(ws + WS_UT);
    bf16_t* OUTB = (bf16_t*)a.out;
    const int lo = a.ph_lo, hi = a.ph_hi;
    volatile LAS unsigned* MISC = (volatile LAS unsigned*)(lds + 131072);
    if (threadIdx.x < 16) MISC[threadIdx.x] = 0u;
    __syncthreads();
    XcdBarrier bar; bar.bar = g_barrier_words; bar.x = 0; bar.st = MISC;
    if (hi - lo > 1) bar = xcd_barrier_post(g_barrier_words, MISC);
#define IN(k) (lo <= (k) && (k) < hi)
#define REP(k) for (int rep_ = 0; rep_ < (((a.rep_mask >> (k)) & 1) ? 2 : 1); ++rep_)
#define SEAM(k) do { if (IN(k) && IN((k) + 1)) xcd_barrier(bar); } while (0)

    if ((a.rep_mask >> 9) & 1) { for (int i_ = 0; i_ < 16; ++i_) grid.sync(); }
    if ((a.rep_mask >> 10) & 1) { for (int i_ = 0; i_ < 16; ++i_) xcd_barrier(bar); }
    if (IN(0)) REP(0) {
        FRESH_TID(tid, lane, wave);
        LAS float* scr = (LAS float*)(lds + wave * 16384);
        const int gw = vcu * 8 + wave, NGW = G * 8;
        constexpr int IF = 4 * 32 * 8;
        constexpr int NB1 = (EVEN_IN - 1024) / 32, I1 = (D / 64) * NB1;
        constexpr int NB2 = D / 32, I2 = (EVEN_W / 64) * NB2, NB3 = ODD_IN / 32, I3 = (D / 64) * NB3, NB4 = D / 32, I4 = (D / 64) * NB4;
        constexpr int NITEMS = IF + I1 + I2 + I3 + I4;
        for (int it = gw; it < NITEMS; it += NGW) {
            int r = it;
            if (r < IF) { p0_fold_item(w_in_even, w_pool, pool_scale, WT1, r, lane); continue; } r -= IF;
            if (r < I1) { const int n0 = 1024 + (r % NB1) * 32; p0_transpose_item(w_in_even, D, EVEN_IN, WT1, 0, scr, 64 * (r / NB1), n0, lane, nullptr, true); continue; } r -= I1;
            if (r < I2) { p0_transpose_item(w_out_even, EVEN_W, D, WT2, 0, scr, 64 * (r / NB2), 32 * (r % NB2), lane); continue; } r -= I2;
            if (r < I3) { p0_transpose_item(w_in_odd, D, ODD_IN, WT3, 0, scr, 64 * (r / NB3), 32 * (r % NB3), lane, norm_g + D); continue; } r -= I3;
            p0_transpose_item(w_out_odd, D, D, WT4, 0, scr, 64 * (r / NB4), 32 * (r % NB4), lane);
        }
        f32x4 gq[4];
#pragma unroll
        for (int j = 0; j < 4; ++j) gq[j] = *((const f32x4*)norm_g + lane + 64 * j);
        for (int mb = gw; mb < M; mb += 4 * NGW) {
            f32x4 v[4][4]; float sq[4];
#pragma unroll
            for (int q = 0; q < 4; ++q) { const f32x4* xr = (const f32x4*)(x + (size_t)(mb + q * NGW) * D) + lane;
#pragma unroll
                for (int j = 0; j < 4; ++j) v[q][j] = __builtin_nontemporal_load(xr + 64 * j); }
#pragma unroll
            for (int q = 0; q < 4; ++q) { float s_ = 0.f;
#pragma unroll
                for (int j = 0; j < 4; ++j) s_ += (v[q][j].x * v[q][j].x + v[q][j].y * v[q][j].y) + (v[q][j].z * v[q][j].z + v[q][j].w * v[q][j].w);
                sq[q] = s_; }
#pragma unroll
            for (int o = 1; o < 64; o <<= 1) {
#pragma unroll
                for (int q = 0; q < 4; ++q) sq[q] += __shfl_xor(sq[q], o); }
#pragma unroll
            for (int q = 0; q < 4; ++q) { const float ms = sq[q] * (1.f / D) + EPS; const float rstd = rsqrtf(ms);
                if (lane == 0) COS  [mb + q * NGW] = sqrtf(ms);
                u32x2* o8 = (u32x2*)(XN + (size_t)(mb + q * NGW) * D) + lane;
#pragma unroll
                for (int j = 0; j < 4; ++j) { u32x2 w; w.x = cvt_pk_bf16(v[q][j].x * rstd * gq[j].x, v[q][j].y * rstd * gq[j].y); w.y = cvt_pk_bf16(v[q][j].z * rstd * gq[j].z, v[q][j].w * rstd * gq[j].w); o8[64 * j] = w; } }
        }
        { float* ropec = (float*)(ws + WS_ROPEC); float* ropes = (float*)(ws + WS_ROPES);
          for (int idx = vcu * 512 + tid; idx < M * 8; idx += G * 512) {
              const float ang = (float)pos[idx >> 3] * INVF[idx & 7]; const float fr_ = __builtin_amdgcn_fractf(ang * 0.15915494309189535f);
              ropec[idx] = __builtin_amdgcn_cosf(fr_); ropes[idx] = __builtin_amdgcn_sinf(fr_); } }
        __syncthreads();
    }
    SEAM(0);
    if (IN(1)) REP(1) {
        pg8::Gemm g{XN, WT1, M, EVEN_IN, D, 0}; pg8::StaticOrder S; S.init(M, EVEN_IN, G, bx);
        pg8::EpiEven E{OUTB, CUS, GZS, U0, Z0, UT, conv_w};
        pg8::gemm_phase<pg8::EpiEven, true>(lds, g, S, E);
    }
    SEAM(1);
    if (IN(2)) REP(2) { FRESH_TID(tid, lane, wave); p2_phase(OUTB, CUS, GZS, U0, Z0, UT, conv_w, vcu * 512 + tid, G * 512); }
    if (IN(2) && IN(4)) xcd_barrier(bar);
    if (IN(4)) REP(4) {
        pg8::Gemm g{OUTB, WT2, M, D, EVEN_W, 0}; pg8::StaticOrder S; S.init(M, D, G, bx);
        pg8::EpiRes1 E{XN  , COS  , norm_g, SS1};
        pg8::gemm_phase(lds, g, S, E);
    }
    SEAM(4);
    if (IN(5)) REP(5) {
        pg8::Gemm g{XN, WT3, M, ODD_IN, D, 0}; pg8::StaticOrder S; S.init(M, ODD_IN, G, bx); if (G == 256) S.tail_round = 4;
        LAS float* rtab = (LAS float*)(lds + RSTD_OFF);
        { FRESH_TID(tid, lane, wave);
          for (int i = tid >> 8; i < 5; i += 2) { pg8::Unit u; if (!S.next(i, u)) break;
              const float* sp = SS1 + (size_t)(u.pm * 256 + (tid & 255)) * 16;
              const f32x4 s0 = *(const f32x4*)sp, s1 = *(const f32x4*)(sp + 4), s2 = *(const f32x4*)(sp + 8), s3 = *(const f32x4*)(sp + 12);
              const float tot = ((s0[0] + s0[1]) + (s0[2] + s0[3])) + ((s1[0] + s1[1]) + (s1[2] + s1[3])) + ((s2[0] + s2[1]) + (s2[2] + s2[3])) + ((s3[0] + s3[1]) + (s3[2] + s3[3]));
              rtab[i * 256 + (tid & 255)] = rsqrtf(tot * (1.0f / D) + EPS); }
          __syncthreads(); }
        pg8::EpiQKVZ E{PROJ1, b_in_odd, (const float*)(ws + WS_ROPEC), (const float*)(ws + WS_ROPES), rtab};
        pg8::gemm_phase<pg8::EpiQKVZ, false, true>(lds, g, S, E);
    }
    SEAM(5);
    if (IN(6)) REP(6) { attn_phase(lds, PROJ1, ATT, sinks, vcu, G); __syncthreads(); }
    SEAM(6);
    if (IN(7)) REP(7) {
        pg8::Gemm g{ATT, WT4, M, D, D, 0}; pg8::StaticOrder S; S.init(M, D, G, bx);
        pg8::EpiFinal E{XN  , a.out, b_out_odd, final_g, SS2  , g_panel_cnt, lds + RSTD_OFF};
        pg8::gemm_phase(lds, g, S, E);
    }
    if (hi - lo > 1) {
        __syncthreads();
        if (threadIdx.x == 0) { const unsigned old = xb_add(&g_barrier_words[XB_EXIT], 1u); MISC[4] = (old + 1u == (unsigned)gridDim.x) ? 1u : 0u; }
        __syncthreads();
        if (MISC[4] != 0u) {
            for (int i_ = threadIdx.x; i_ < XCD_BAR_WORDS; i_ += 512) __hip_atomic_store(&g_barrier_words[i_], 0u, __ATOMIC_RELAXED, __HIP_MEMORY_SCOPE_AGENT);
            for (int i_ = threadIdx.x; i_ < 128 * 16; i_ += 512) __hip_atomic_store(&g_panel_cnt[i_], 0u, __ATOMIC_RELAXED, __HIP_MEMORY_SCOPE_AGENT);
            __builtin_amdgcn_fence(__ATOMIC_RELEASE, "agent");
        }
    }
#undef IN
#undef SEAM
}

extern "C" void kernel_launch(void* const* d_in, const int* in_sizes, int n_in, void* d_out, int out_size, void* d_ws, size_t ws_size, hipStream_t stream) {
    static int grid = 0;
    if (grid == 0) {
        if (n_in != 14 || in_sizes[0] != M * D || out_size != M * D || ws_size < WS_END) {
            fprintf(stderr, "kernel_launch: shape/workspace mismatch (n_in %d, in0 %d, out %d, ws %zu); nothing launched\n", n_in, n_in > 0 ? in_sizes[0] : -1, out_size, ws_size); grid = -1; return; }
        int dev = 0, cus = 0, per_cu = 0;
        if (hipGetDevice(&dev) != hipSuccess || hipDeviceGetAttribute(&cus, hipDeviceAttributeMultiprocessorCount, dev) != hipSuccess) { grid = -1; return; }
        if (hipFuncSetAttribute((const void*)fwd_megakernel, hipFuncAttributeMaxDynamicSharedMemorySize, LDS_BYTES) != hipSuccess) { fprintf(stderr, "kernel_launch: hipFuncSetAttribute failed\n"); grid = -1; return; }
        if (hipOccupancyMaxActiveBlocksPerMultiprocessor(&per_cu, (const void*)fwd_megakernel, 512, LDS_BYTES) != hipSuccess || per_cu < 1) { fprintf(stderr, "kernel_launch: occupancy query says %d\n", per_cu); per_cu = 1; }
        (void)hipGetLastError();
        grid = cus * 1;
    }
    if (grid < 0) return;
    Args a{};
    for (int i = 0; i < 14; ++i) a.in[i] = d_in[i];
    a.out = (float*)d_out; a.ws = (unsigned char*)d_ws; a.rep_mask = PROBE_MASK;
#if MK_N_LAUNCHES == 1
    a.ph_lo = 0; a.ph_hi = 9;
    void* args[] = {&a};
    hipError_t e = hipLaunchCooperativeKernel((const void*)fwd_megakernel, dim3(grid), dim3(512), args, LDS_BYTES, stream);
    if (e != hipSuccess) fprintf(stderr, "cooperative launch failed: %s (grid %d)\n", hipGetErrorString(e), grid);
#else
    for (int p = 0; p < 9; ++p) { a.ph_lo = p; a.ph_hi = p + 1; hipLaunchKernelGGL(fwd_megakernel, dim3(grid), dim3(512), LDS_BYTES, stream, a); }
#endif
}
```

```cpp
#include <hip/hip_runtime.h>
#include <hip/hip_cooperative_groups.h>
#include <cstdio>
#include <cstdint>
#include <cmath>
namespace cg = cooperative_groups;

#ifndef PROBE_MASK
#define PROBE_MASK 0
#endif
#ifndef MK_N_LAUNCHES
#define MK_N_LAUNCHES 1
#endif

#define LAS __attribute__((address_space(3)))
#define GAS __attribute__((address_space(1)))
typedef unsigned short bf16_t;
typedef short bf16x8 __attribute__((ext_vector_type(8)));
typedef short s16x4 __attribute__((ext_vector_type(4)));
typedef float f32x4 __attribute__((ext_vector_type(4)));
typedef float f32x16 __attribute__((ext_vector_type(16)));
typedef unsigned u32x4 __attribute__((ext_vector_type(4)));
typedef unsigned u32x2 __attribute__((ext_vector_type(2)));

constexpr int BATCH = 4, SEQ = 8192, D = 1024, M = BATCH * SEQ;
constexpr int EVEN_IN = 6144, EVEN_W = 2048, ODD_IN = 2304;
constexpr int NHEAD = 16, HD = 64;
constexpr float EPS = 1e-5f;
constexpr float LOG2E = 1.4426950408889634f;
constexpr float C2 = 0.125f * LOG2E;

constexpr size_t MiB = 1u << 20;
constexpr size_t WS_SS1 = 0;
constexpr size_t WS_SS2 = 2 * MiB;
constexpr size_t WS_COS = 4 * MiB;
constexpr size_t WS_ROPEC = 5 * MiB, WS_ROPES = 6 * MiB;
constexpr size_t WS_WT1 = 8 * MiB, WS_WT2 = 21 * MiB, WS_WT3 = 25 * MiB, WS_WT4 = 30 * MiB;
constexpr size_t WS_XN = 32 * MiB;
constexpr size_t WS_PROJ1 = 96 * MiB;
constexpr size_t WS_ATT = 240 * MiB;
constexpr size_t WS_CUS = 368 * MiB;
constexpr size_t WS_GZS = 372 * MiB;
constexpr size_t WS_U0 = 376 * MiB;
constexpr size_t WS_Z0 = 384 * MiB;
constexpr size_t WS_UT = 392 * MiB;
constexpr size_t WS_END = 400 * MiB;

__device__ __forceinline__ unsigned cvt_pk_bf16(float lo, float hi) { unsigned r; asm volatile("v_cvt_pk_bf16_f32 %0, %1, %2" : "=v"(r) : "v"(lo), "v"(hi)); return r; }
__device__ __forceinline__ float bf_lo(unsigned w) { return __uint_as_float(w << 16); }
__device__ __forceinline__ float bf_hi(unsigned w) { return __uint_as_float(w & 0xffff0000u); }
__device__ __forceinline__ u32x4 pack8v(const float (&f)[8]) { u32x4 w; w.x = cvt_pk_bf16(f[0], f[1]); w.y = cvt_pk_bf16(f[2], f[3]); w.z = cvt_pk_bf16(f[4], f[5]); w.w = cvt_pk_bf16(f[6], f[7]); return w; }
__device__ __forceinline__ float silu_f(float z) { return z * __builtin_amdgcn_rcpf(1.0f + __builtin_amdgcn_exp2f(-LOG2E * z)); }

namespace pg8 {
constexpr int BM = 256, BK = 64, HALF = 128, HTB = HALF * BK * 2, STAGE_BYTES = 8 * HTB, NXCD = 8, WGM = 8;
__host__ __device__ __forceinline__ int lds_byte(int r, int c) { const int st = (r >> 4) * 2 + (c >> 5), rr = r & 15, cc = c & 31, ob = rr * 64 + cc * 2; return st * 1024 + (ob ^ (((ob >> 9) & 1) << 5)); }
__host__ __device__ __forceinline__ void stage_rc(int b, int& R, int& C) { const int st = b / 1024, sb = b % 1024, swz = sb ^ (((sb >> 9) & 1) << 5); R = (st >> 1) * 16 + swz / 64; C = (st & 1) * 32 + (swz % 64) / 2; }
__host__ __device__ __forceinline__ int perm32(int rho) { const int n = rho >> 4, i = rho & 15; return 8 * (i >> 2) + 4 * n + (i & 3); }

struct Unit { int pm, pn, idx, half; };
struct Gemm { const bf16_t* A; const bf16_t* Bt; int M, N, K; size_t a_pn_stride; };

struct StaticOrder {
    int nM, nN, nwg, G, c;
    __host__ __device__ void init(int M_, int N_, int G_, int c_) { nM = M_ / BM; nN = N_ / BM; nwg = nM * nN; G = G_; c = c_; }
    int tail_round = -1;
    __host__ __device__ bool next(int i, Unit& u) const {
        u.half = -1;
        int wgid;
        if (tail_round >= 0 && i >= tail_round) {
            if (i > tail_round) return false;
            const int xcd = c & 7, k = c >> 3;
            wgid = xcd * (nwg / NXCD) + tail_round * 32 + (k >> 1); u.half = k & 1;
        } else {
        const long L = (long)i * G + c; if (L >= nwg) return false;
        wgid = (int)L; { const int q = nwg / NXCD, r = nwg % NXCD, xcd = wgid % NXCD, off = wgid / NXCD; wgid = (xcd < r ? xcd * (q + 1) : r * (q + 1) + (xcd - r) * q) + off; }
        }
        const int nig = WGM * nN, gid = wgid / nig, fm = gid * WGM, gsz = (nM - fm) < WGM ? (nM - fm) : WGM;
        u.pm = fm + ((wgid % nig) % gsz); u.pn = (wgid % nig) / gsz; u.idx = i; return true;
    }
};

template <class Epi, bool RP = false, bool TS = false>
__device__ __forceinline__ void gemm_phase(LAS unsigned char* lds, const Gemm g, const StaticOrder& S, const Epi& E) {
    int tid = threadIdx.x; asm volatile("" : "+v"(tid));
    const int wid = __builtin_amdgcn_readfirstlane(tid >> 6), lane = tid & 63, wr = wid >> 2, wc = wid & 3, fr = lane & 15, fq = lane >> 4;
    const int K = g.K, nt = K / BK;
    unsigned voffA[2], voffB[2];
#pragma unroll
    for (int i = 0; i < 2; ++i) { int R, C; stage_rc(tid * 16 + i * 8192, R, C); const int Rb = (R & ~31) + perm32(R & 31); const int Ra = RP ? (128 * (R >> 6) + (R & 63)) : R;
        voffA[i] = (unsigned)(Ra * K + C) * 2u; voffB[i] = (unsigned)(Rb * K + C) * 2u; }
    const size_t kstep = (size_t)(BK * 2);
    const size_t hstep = (size_t)HALF * K * 2;
    const size_t tstep = 2 * hstep;
    const size_t hstepA = RP ? (size_t)64 * K * 2 : hstep;
    const unsigned ldsw = (unsigned)wid * 1024u;
    const int aoff = lds_byte(wr * 64 + fr, fq * 8), boff = lds_byte(wc * 32 + fr, fq * 8);
#define PG8_SA(b, h) (((b) * 2 + (h)) * HTB)
#define PG8_SB(b, h) ((4 + (b) * 2 + (h)) * HTB)
#define PG8_STAGE(bufoff, gbase, voff) do { _Pragma("unroll") for (int _i = 0; _i < 2; ++_i) \
        __builtin_amdgcn_global_load_lds((const unsigned*)((const char*)(gbase) + (voff)[_i]), (LAS unsigned*)(lds + (bufoff) + ldsw + _i * 8192), 16, 0, 0); } while (0)
#define PG8_LDA(dst, b, h) do { _Pragma("unroll") for (int m = 0; m < 4; ++m) _Pragma("unroll") for (int k = 0; k < 2; ++k) dst[m][k] = *(const LAS bf16x8*)(lds + PG8_SA(b, h) + aoff + m * 2048 + k * 1024); } while (0)
#define PG8_LDB(dst, b, h) do { _Pragma("unroll") for (int n = 0; n < 2; ++n) _Pragma("unroll") for (int k = 0; k < 2; ++k) dst[n][k] = *(const LAS bf16x8*)(lds + PG8_SB(b, h) + boff + n * 2048 + k * 1024); } while (0)
#define PG8_MMA(ai, bj, At, Bt) do { __builtin_amdgcn_s_setprio(1); _Pragma("unroll") for (int m = 0; m < 4; ++m) _Pragma("unroll") for (int n = 0; n < 2; ++n) _Pragma("unroll") for (int k = 0; k < 2; ++k) \
        acc[ai][bj][m][n] = __builtin_amdgcn_mfma_f32_16x16x32_bf16(Bt[n][k], At[m][k], acc[ai][bj][m][n], 0, 0, 0); __builtin_amdgcn_s_setprio(0); } while (0)
#define PG8_WAIT_V(n) asm volatile("s_waitcnt vmcnt(" #n ")" ::: "memory")
#define PG8_WAIT_L(n) asm volatile("s_waitcnt lgkmcnt(" #n ")" ::: "memory")
#define PG8_BAR __builtin_amdgcn_s_barrier()
#define PG8_SCHED __builtin_amdgcn_sched_barrier(0)
    Unit cur, nxt; int ui = 0;
    if (!S.next(0, cur)) return;
    f32x4 acc[2][2][4][2];
#pragma unroll
    for (int a = 0; a < 2; ++a)
#pragma unroll
        for (int b = 0; b < 2; ++b)
#pragma unroll
            for (int m = 0; m < 4; ++m)
#pragma unroll
                for (int n = 0; n < 2; ++n) acc[a][b][m][n] = (f32x4){0.f, 0.f, 0.f, 0.f};
    bf16x8 At[4][2], B0[2][2], B1[2][2];
    const char* cA = (const char*)g.A + (size_t)cur.pm * tstep + (size_t)cur.pn * g.a_pn_stride; const char* cB = (const char*)g.Bt + (size_t)cur.pn * tstep + ((TS && cur.half == 1) ? hstep : 0);
    bool fullc = !(TS && cur.half >= 0);
    PG8_STAGE(PG8_SB(0, 0), cB, voffB); PG8_STAGE(PG8_SB(0, 1), cB + hstep, voffB); PG8_STAGE(PG8_SA(0, 0), cA, voffA); PG8_STAGE(PG8_SA(0, 1), cA + hstepA, voffA);
    if (wr == 1) PG8_BAR;
    PG8_WAIT_V(2); PG8_BAR;
    PG8_STAGE(PG8_SB(1, 0), cB + kstep, voffB); PG8_STAGE(PG8_SA(1, 0), cA + kstep, voffA); PG8_STAGE(PG8_SB(1, 1), cB + hstep + kstep, voffB);
    PG8_WAIT_V(6); PG8_BAR;
    for (;;) {
        const bool has_next = S.next(ui + 1, nxt);
        const char* nA = has_next ? (const char*)g.A + (size_t)nxt.pm * tstep + (size_t)nxt.pn * g.a_pn_stride : cA; const char* nB = has_next ? (const char*)g.Bt + (size_t)nxt.pn * tstep + ((TS && nxt.half == 1) ? hstep : 0) : cB;
        for (int t = 0; t < nt; t += 2) {
            const bool last = (t == nt - 2);
            const char* a1 = cA + (size_t)(t + 1) * kstep;
            const char* a2 = last ? nA : cA + (size_t)(t + 2) * kstep; const char* b2 = last ? nB : cB + (size_t)(t + 2) * kstep;
            const char* a3 = a2 + kstep; const char* b3 = b2 + kstep;
            PG8_LDB(B0, 0, 0); if (!TS || fullc) PG8_LDB(B1, 0, 1); PG8_SCHED; PG8_LDA(At, 0, 0); PG8_STAGE(PG8_SA(1, 1), a1 + hstepA, voffA);
            PG8_WAIT_V(8); PG8_WAIT_L(0); PG8_BAR; PG8_MMA(0, 0, At, B0); if (!TS || fullc) PG8_MMA(0, 1, At, B1); PG8_BAR; PG8_SCHED;
            PG8_LDA(At, 0, 1); PG8_STAGE(PG8_SB(0, 0), b2, voffB); PG8_STAGE(PG8_SB(0, 1), b2 + hstep, voffB); PG8_STAGE(PG8_SA(0, 0), a2, voffA);
            PG8_WAIT_V(8); PG8_WAIT_L(0); PG8_BAR; PG8_MMA(1, 0, At, B0); if (!TS || fullc) PG8_MMA(1, 1, At, B1); PG8_BAR; PG8_SCHED;
            PG8_LDB(B0, 1, 0); if (!TS || fullc) PG8_LDB(B1, 1, 1); PG8_SCHED; PG8_LDA(At, 1, 0); PG8_STAGE(PG8_SA(0, 1), a2 + hstepA, voffA);
            PG8_WAIT_V(8); PG8_WAIT_L(0); PG8_BAR; PG8_MMA(0, 0, At, B0); if (!TS || fullc) PG8_MMA(0, 1, At, B1); PG8_BAR; PG8_SCHED;
            PG8_LDA(At, 1, 1); PG8_STAGE(PG8_SB(1, 0), b3, voffB); PG8_STAGE(PG8_SB(1, 1), b3 + hstep, voffB); PG8_STAGE(PG8_SA(1, 0), a3, voffA);
            PG8_WAIT_V(8); PG8_WAIT_L(0); PG8_BAR; PG8_MMA(1, 0, At, B0); if (!TS || fullc) PG8_MMA(1, 1, At, B1); PG8_BAR; PG8_SCHED;
        }
        if (wr == 0) PG8_BAR;
        E(acc, cur, wr, wc, fr, fq);
        if (!has_next) break;
#pragma unroll
        for (int a = 0; a < 2; ++a)
#pragma unroll
            for (int b = 0; b < 2; ++b)
#pragma unroll
                for (int m = 0; m < 4; ++m)
#pragma unroll
                    for (int n = 0; n < 2; ++n) acc[a][b][m][n] = (f32x4){0.f, 0.f, 0.f, 0.f};
        cur = nxt; cA = nA; cB = nB; ++ui; fullc = !(TS && cur.half >= 0);
        if (wr == 1) PG8_BAR;
    }
    PG8_WAIT_V(0);
    PG8_BAR;
#undef PG8_SA
#undef PG8_SB
#undef PG8_STAGE
#undef PG8_LDA
#undef PG8_LDB
#undef PG8_MMA
#undef PG8_WAIT_V
#undef PG8_WAIT_L
#undef PG8_BAR
#undef PG8_SCHED
}

typedef f32x4 Acc[2][2][4][2];

template <int CTRL> __device__ __forceinline__ float dppz(float v) { return __builtin_bit_cast(float, __builtin_amdgcn_update_dpp(0, __builtin_bit_cast(int, v), CTRL, 0xf, 0xf, true)); }
__device__ __forceinline__ float scan_up(float v) { v += dppz<0x111>(v); v += dppz<0x112>(v); v += dppz<0x114>(v); v += dppz<0x118>(v); return v; }
__device__ __forceinline__ float scan_dn(float v) { v += dppz<0x101>(v); v += dppz<0x102>(v); v += dppz<0x104>(v); v += dppz<0x108>(v); return v; }

struct EpiEven {
    bf16_t* OUT; bf16_t* CUS; bf16_t* GZS; bf16_t* U0; bf16_t* Z0; bf16_t* UT; const float* conv_w;
    template <int W> __device__ __forceinline__ void pooled(const Acc& acc, const Unit& u, int wr, int wc, int fr, int fq) const {
        const int chl = 128 * u.pn + 32 * wc + 8 * fq;
        const int blk = u.pm * 2 + wr;
        const size_t rowb = (size_t)u.pm * BM + wr * 128 + fr;
        float qprev[8];
#pragma unroll
        for (int e = 0; e < 8; ++e) qprev[e] = 0.f;
#pragma unroll
        for (int g8 = 0; g8 < 8; ++g8) { const int ai = g8 >> 2, m = g8 & 3;
            float uu[8], zz[8], o[8];
#pragma unroll
            for (int n = 0; n < 2; ++n)
#pragma unroll
                for (int j = 0; j < 4; ++j) { uu[4 * n + j] = acc[ai][0][m][n][j]; zz[4 * n + j] = silu_f(acc[ai][1][m][n][j]); }
#pragma unroll
            for (int e = 0; e < 8; ++e) {
                float cur = uu[e], q = uu[e];
                if constexpr (W >= 2)  { cur += dppz<0x111>(cur); q += dppz<0x101>(q); }
                if constexpr (W >= 4)  { cur += dppz<0x112>(cur); q += dppz<0x102>(q); }
                if constexpr (W >= 8)  { cur += dppz<0x114>(cur); q += dppz<0x104>(q); }
                if constexpr (W >= 16) { cur += dppz<0x118>(cur); q += dppz<0x108>(q); }
                const float prv = dppz<0x100 + ((17 - W) & 15)>(qprev[e]);
                o[e] = ((cur + prv) * (1.0f / W) - uu[e]) * zz[e]; qprev[e] = q; }
            const size_t row = rowb + ai * 64 + m * 16;
            if (!(g8 == 0 && fr < 15)) *(u32x4*)(OUT + row * EVEN_W + chl) = pack8v(o);
            if (g8 == 0 && fr < 15) { *(u32x4*)(U0 + ((size_t)blk * 15 + fr) * 1024 + chl) = pack8v(uu); *(u32x4*)(Z0 + ((size_t)blk * 15 + fr) * 1024 + chl) = pack8v(zz); }
            if (g8 == 7 && fr >= 1) *(u32x4*)(UT + ((size_t)blk * 15 + fr - 1) * 1024 + chl) = pack8v(uu);
        }
    }
    __device__ __forceinline__ void operator()(const Acc& acc, const Unit& u, int wr, int wc, int fr, int fq) const {
        const int pn = u.pn;
        if (pn < 8) {
            switch (pn >> 1) { case 0: pooled<2>(acc, u, wr, wc, fr, fq); break; case 1: pooled<4>(acc, u, wr, wc, fr, fq); break;
                               case 2: pooled<8>(acc, u, wr, wc, fr, fq); break; default: pooled<16>(acc, u, wr, wc, fr, fq); break; }
        } else {
            const int row0 = u.pm * BM + wr * 128 + fr;
            const int ch0 = 64 * (pn - 8) + 16 * wc + 4 * fq;
            const f32x4 cw0 = *(const f32x4*)(conv_w + ch0), cw1 = *(const f32x4*)(conv_w + 1024 + ch0), cw2 = *(const f32x4*)(conv_w + 2048 + ch0);
#pragma unroll
            for (int ai = 0; ai < 2; ++ai) {
                const int grp = u.pm * 4 + wr * 2 + ai;
                f32x4 cup = (f32x4){0.f, 0.f, 0.f, 0.f};
#pragma unroll
                for (int m = 0; m < 4; ++m) {
                    const f32x4 cu = acc[ai][0][m][0] * acc[ai][0][m][1];
                    f32x4 gz = acc[ai][1][m][1];
#pragma unroll
                    for (int j = 0; j < 4; ++j) gz[j] = silu_f(gz[j]);
                    gz = gz * acc[ai][1][m][0];
                    f32x4 o;
#pragma unroll
                    for (int j = 0; j < 4; ++j) {
                        const float q1 = dppz<0x111>(cu[j]) + dppz<0x10F>(cup[j]);
                        const float q2 = dppz<0x112>(cu[j]) + dppz<0x10E>(cup[j]);
                        o[j] = gz[j] * (cw2[j] * cu[j] + cw1[j] * q1 + cw0[j] * q2); }
                    cup = cu;
                    const size_t row = (size_t)(row0 + ai * 64 + m * 16);
                    u32x2 w; w.x = cvt_pk_bf16(o[0], o[1]); w.y = cvt_pk_bf16(o[2], o[3]);
                    if (!(m == 0 && fr < 2)) *(u32x2*)(OUT + row * EVEN_W + 1024 + ch0) = w;
                    if (m == 0 && fr < 2) { u32x2 c2; c2.x = cvt_pk_bf16(cu[0], cu[1]); c2.y = cvt_pk_bf16(cu[2], cu[3]); u32x2 g2; g2.x = cvt_pk_bf16(gz[0], gz[1]); g2.y = cvt_pk_bf16(gz[2], gz[3]);
                        *(u32x2*)(CUS + (size_t)(grp * 4 + fr) * 1024 + ch0) = c2; *(u32x2*)(GZS + (size_t)(grp * 2 + fr) * 1024 + ch0) = g2; }
                    if (m == 3 && fr >= 14) { u32x2 c2; c2.x = cvt_pk_bf16(cu[0], cu[1]); c2.y = cvt_pk_bf16(cu[2], cu[3]);
                        *(u32x2*)(CUS + (size_t)(grp * 4 + 2 + (fr - 14)) * 1024 + ch0) = c2; }
                }
            }
        }
    }
};

struct EpiRes1 {
    bf16_t* h1b; const float* rs0  ; const float* g0; float* ss;
    __device__ __forceinline__ void operator()(const Acc& acc, const Unit& u, int wr, int wc, int fr, int fq) const {
        const int row0 = u.pm * BM + wr * 64 + fr, col0 = u.pn * BM + wc * 32 + 8 * fq;
        f32x4 ig[2][2]; float rs[2][4];
#pragma unroll
        for (int bj = 0; bj < 2; ++bj)
#pragma unroll
            for (int n = 0; n < 2; ++n) { const f32x4 g = *(const f32x4*)(g0 + col0 + bj * HALF + 4 * n); ig[bj][n] = (f32x4){1.0f / g[0], 1.0f / g[1], 1.0f / g[2], 1.0f / g[3]}; }
#pragma unroll
        for (int ai = 0; ai < 2; ++ai)
#pragma unroll
            for (int m = 0; m < 4; ++m) rs[ai][m] = rs0[row0 + ai * HALF + m * 16];
#pragma unroll
        for (int ai = 0; ai < 2; ++ai)
#pragma unroll
            for (int m = 0; m < 4; ++m) { const size_t row = (size_t)(row0 + ai * HALF + m * 16); float sq = 0.f; const float r_ = rs[ai][m];
#pragma unroll
                for (int bj = 0; bj < 2; ++bj) { const size_t off = row * D + col0 + bj * HALF;
                    const u32x4 h = *(const u32x4*)(h1b + off);
                    const f32x4 x0 = (f32x4){bf_lo(h.x), bf_hi(h.x), bf_lo(h.y), bf_hi(h.y)} * r_ * ig[bj][0], x1 = (f32x4){bf_lo(h.z), bf_hi(h.z), bf_lo(h.w), bf_hi(h.w)} * r_ * ig[bj][1];
                    const f32x4 v0 = acc[ai][bj][m][0] + x0, v1 = acc[ai][bj][m][1] + x1;
                    sq += (v0[0] * v0[0] + v0[1] * v0[1]) + (v0[2] * v0[2] + v0[3] * v0[3]) + (v1[0] * v1[0] + v1[1] * v1[1]) + (v1[2] * v1[2] + v1[3] * v1[3]);
                    u32x4 w; w.x = cvt_pk_bf16(v0[0], v0[1]); w.y = cvt_pk_bf16(v0[2], v0[3]); w.z = cvt_pk_bf16(v1[0], v1[1]); w.w = cvt_pk_bf16(v1[2], v1[3]);
                    *(u32x4*)(h1b + off) = w; }
                sq += __shfl_xor(sq, 16); sq += __shfl_xor(sq, 32);
                if (fq == 0) ss[row * 16 + u.pn * 4 + wc] = sq; }
    }
};
struct EpiFinal {
    const bf16_t* h1b; float* out; const float* bias; const float* gF; float* slots; unsigned* cnt; LAS unsigned char* xl;
    __device__ __forceinline__ void operator()(Acc& acc, const Unit& u, int wr, int wc, int fr, int fq) const {
        LAS float* P = (LAS float*)xl;
        LAS float* S = (LAS float*)(xl + 4096);
        int tid = threadIdx.x; asm volatile("" : "+v"(tid));
        const int lane = tid & 63, wid = __builtin_amdgcn_readfirstlane(tid >> 6);
        const int row0 = u.pm * BM + wr * 64 + fr, col0 = u.pn * BM + wc * 32 + 8 * fq;
        f32x4 bv[2][2];
#pragma unroll
        for (int bj = 0; bj < 2; ++bj)
#pragma unroll
            for (int n = 0; n < 2; ++n) bv[bj][n] = *(const f32x4*)(bias + col0 + bj * HALF + 4 * n);
#pragma unroll
        for (int ai = 0; ai < 2; ++ai)
#pragma unroll
            for (int m = 0; m < 4; ++m) { const size_t row = (size_t)(row0 + ai * HALF + m * 16); float sq = 0.f;
#pragma unroll
                for (int bj = 0; bj < 2; ++bj) { const u32x4 h = *(const u32x4*)(h1b + row * D + col0 + bj * HALF);
                    const f32x4 r0 = (f32x4){bf_lo(h.x), bf_hi(h.x), bf_lo(h.y), bf_hi(h.y)}, r1 = (f32x4){bf_lo(h.z), bf_hi(h.z), bf_lo(h.w), bf_hi(h.w)};
                    const f32x4 v0 = acc[ai][bj][m][0] + bv[bj][0] + r0, v1 = acc[ai][bj][m][1] + bv[bj][1] + r1;
                    acc[ai][bj][m][0] = v0; acc[ai][bj][m][1] = v1;
                    sq += (v0[0] * v0[0] + v0[1] * v0[1]) + (v0[2] * v0[2] + v0[3] * v0[3]) + (v1[0] * v1[0] + v1[1] * v1[1]) + (v1[2] * v1[2] + v1[3] * v1[3]); }
                sq += __shfl_xor(sq, 16); sq += __shfl_xor(sq, 32);
                if (fq == 0) P[(ai * HALF + wr * 64 + m * 16 + fr) * 4 + wc] = sq; }
        asm volatile("s_waitcnt lgkmcnt(0)" ::: "memory"); __builtin_amdgcn_s_barrier(); asm volatile("" ::: "memory");
        if (tid < 256) { const float t_ = (P[tid * 4 + 0] + P[tid * 4 + 1]) + (P[tid * 4 + 2] + P[tid * 4 + 3]);
            __hip_atomic_store(slots + ((size_t)(u.pm * BM + tid) * 4 + u.pn), t_, __ATOMIC_RELAXED, __HIP_MEMORY_SCOPE_AGENT); }
        asm volatile("s_waitcnt vmcnt(0)" ::: "memory");
        if (lane == 0 && wid < 4) __hip_atomic_fetch_add(cnt + 16 * u.pm, 1u, __ATOMIC_RELAXED, __HIP_MEMORY_SCOPE_AGENT);
        if (wid == 0) { unsigned sp = 0;
            while ((unsigned)__builtin_amdgcn_readfirstlane((int)__hip_atomic_load(cnt + 16 * u.pm, __ATOMIC_RELAXED, __HIP_MEMORY_SCOPE_AGENT)) < 16u) { __builtin_amdgcn_s_sleep(1); if (++sp > (1u << 22)) break; }
            __builtin_amdgcn_fence(__ATOMIC_ACQUIRE, "agent"); }
        asm volatile("s_waitcnt vmcnt(0) lgkmcnt(0)" ::: "memory"); __builtin_amdgcn_s_barrier(); asm volatile("" ::: "memory");
        if (tid < 256) { const float* sl = slots + (size_t)(u.pm * BM + tid) * 4; float t_ = 0.f;
#pragma unroll
            for (int k = 0; k < 4; ++k) t_ += __hip_atomic_load(sl + k, __ATOMIC_RELAXED, __HIP_MEMORY_SCOPE_AGENT);
            S[tid] = rsqrtf(t_ * (1.0f / D) + EPS); }
        asm volatile("s_waitcnt lgkmcnt(0)" ::: "memory"); __builtin_amdgcn_s_barrier(); asm volatile("" ::: "memory");
        f32x4 gv[2][2];
#pragma unroll
        for (int bj = 0; bj < 2; ++bj)
#pragma unroll
            for (int n = 0; n < 2; ++n) gv[bj][n] = *(const f32x4*)(gF + col0 + bj * HALF + 4 * n);
#pragma unroll
        for (int ai = 0; ai < 2; ++ai)
#pragma unroll
            for (int m = 0; m < 4; ++m) { const size_t row = (size_t)(row0 + ai * HALF + m * 16); const float rs = S[ai * HALF + wr * 64 + m * 16 + fr];
#pragma unroll
                for (int bj = 0; bj < 2; ++bj) { float* op = out + row * D + col0 + bj * HALF;
                    *(f32x4*)op = acc[ai][bj][m][0] * rs * gv[bj][0]; *(f32x4*)(op + 4) = acc[ai][bj][m][1] * rs * gv[bj][1]; } }
    }
};

struct EpiQKVZ {
    bf16_t* O; const float* bias; const float* cosT; const float* sinT; const LAS float* rstd_lds;
    __device__ __forceinline__ void operator()(const Acc& acc, const Unit& u, int wr, int wc, int fr, int fq) const {
        const int row0 = u.pm * BM + wr * 64 + fr, col0 = u.pn * BM + wc * 32 + 8 * fq;
        const int pn = u.pn;
        const bool halfu = u.half >= 0;
        f32x4 bv[2][2];
#pragma unroll
        for (int bj = 0; bj < 2; ++bj)
#pragma unroll
            for (int n = 0; n < 2; ++n) bv[bj][n] = *(const f32x4*)(bias + col0 + (halfu ? u.half : bj) * HALF + 4 * n);
        const bool rot_wave = ((wc & 1) == 0) && (pn <= 4);
        const LAS float* rl = rstd_lds + u.idx * 256 + wr * 64 + fr;
#pragma unroll
        for (int ai = 0; ai < 2; ++ai)
#pragma unroll
            for (int m = 0; m < 4; ++m) { const size_t row = (size_t)(row0 + ai * HALF + m * 16);
                const float rstd = rl[ai * HALF + m * 16];
                f32x4 cs[2], sn[2];
                if (rot_wave) { cs[0] = *(const f32x4*)(cosT + row * 8); cs[1] = *(const f32x4*)(cosT + row * 8 + 4); sn[0] = *(const f32x4*)(sinT + row * 8); sn[1] = *(const f32x4*)(sinT + row * 8 + 4); }
                else { cs[0] = cs[1] = sn[0] = sn[1] = (f32x4){0.f, 0.f, 0.f, 0.f}; }
#pragma unroll
                for (int bj = 0; bj < 2; ++bj) {
                    if (halfu && bj == 1) continue;
                    const int cb = halfu ? u.half : bj;
                    f32x4 v[2];
                    v[0] = acc[ai][bj][m][0] * rstd + bv[bj][0]; v[1] = acc[ai][bj][m][1] * rstd + bv[bj][1];
                    const bool is_q = pn < 4, is_k = (pn == 4 && cb == 0), is_z = pn > 4;
                    if (rot_wave && (is_q || is_k)) {
#pragma unroll
                        for (int n = 0; n < 2; ++n)
#pragma unroll
                            for (int j = 0; j < 4; ++j) { const float x = v[n][j]; const float p = __shfl_xor(x, 16);
                                const float r0 = x * cs[n][j] - p * sn[n][j], r1 = x * cs[n][j] + p * sn[n][j];
                                v[n][j] = (fq == 0) ? r0 : ((fq == 1) ? r1 : x); }
                    }
                    if (is_q) { v[0] = v[0] * C2; v[1] = v[1] * C2; }
                    if (is_z) {
#pragma unroll
                        for (int n = 0; n < 2; ++n)
#pragma unroll
                            for (int j = 0; j < 4; ++j) v[n][j] = silu_f(v[n][j]); }
                    u32x4 w; w.x = cvt_pk_bf16(v[0][0], v[0][1]); w.y = cvt_pk_bf16(v[0][2], v[0][3]); w.z = cvt_pk_bf16(v[1][0], v[1][1]); w.w = cvt_pk_bf16(v[1][2], v[1][3]);
                    __builtin_nontemporal_store(w, (u32x4*)(O + row * ODD_IN + col0 + cb * HALF)); } }
    }
};
}

__device__ __forceinline__ float wave_sum(float v) {
#pragma unroll
    for (int o = 1; o < 64; o <<= 1) v += __shfl_xor(v, o);
    return v;
}
__device__ __forceinline__ int even_dst_row(int s);
__device__ __forceinline__ void p0_transpose_item(const float* W, int K, int N, bf16_t* WT, int row_off, LAS float* scr, int k0, int n0, int lane, const float* kscale = nullptr, bool evenmap = false) {
#pragma unroll
    for (int i = 0; i < 32; ++i) { const int kk = 2 * i + (lane >> 5); float wv = __builtin_nontemporal_load(W + (size_t)(k0 + kk) * N + n0 + (lane & 31)); if (kscale) wv *= kscale[k0 + kk]; scr[kk * 33 + (lane & 31)] = wv; }
    asm volatile("s_waitcnt lgkmcnt(0)" ::: "memory");
    const int c = lane & 7;
#pragma unroll
    for (int j = 0; j < 4; ++j) { const int n = (lane >> 3) + 8 * j; const LAS float* s = scr + (8 * c) * 33 + n;
        u32x4 o; o.x = cvt_pk_bf16(s[0 * 33], s[1 * 33]); o.y = cvt_pk_bf16(s[2 * 33], s[3 * 33]); o.z = cvt_pk_bf16(s[4 * 33], s[5 * 33]); o.w = cvt_pk_bf16(s[6 * 33], s[7 * 33]);
        const int drow = evenmap ? even_dst_row(n0 + n) : row_off + n0 + n;
        *(u32x4*)(WT + (size_t)drow * K + k0 + 8 * c) = o; }
    asm volatile("s_waitcnt lgkmcnt(0)" ::: "memory");
}

__device__ __forceinline__ void p0_fold_item(const float* Win, const float* Wp, const float* ps, bf16_t* WT1, int item, int lane) {
    const int dt = item & 7, kt = (item >> 3) & 31, g = item >> 8;
    const int r32 = lane & 31, hi = lane >> 5, k0 = kt * 32, d0 = dt * 32;
    const float* ap = Win + (size_t)(k0 + r32) * EVEN_IN + g * 256 + 16 * hi;
    const float* bp = Wp + (size_t)g * 65536 + (size_t)(16 * hi) * 256 + d0 + r32;
    f32x16 acc;
#pragma unroll
    for (int r = 0; r < 16; ++r) acc[r] = 0.f;
    f32x4 a4[2][4]; float b[2][16];
#pragma unroll
    for (int q = 0; q < 4; ++q) a4[0][q] = *(const f32x4*)(ap + 4 * q);
#pragma unroll
    for (int j = 0; j < 16; ++j) b[0][j] = bp[(size_t)j * 256];
#pragma unroll
    for (int ci = 0; ci < 8; ++ci) { const int cb = ci & 1, nb = cb ^ 1, base = 32 * (ci + 1);
        if (ci < 7) {
#pragma unroll
            for (int q = 0; q < 4; ++q) a4[nb][q] = *(const f32x4*)(ap + base + 4 * q);
#pragma unroll
            for (int j = 0; j < 16; ++j) b[nb][j] = bp[(size_t)(base + j) * 256]; }
#pragma unroll
        for (int j = 0; j < 16; ++j) acc = __builtin_amdgcn_mfma_f32_32x32x2f32(a4[cb][j >> 2][j & 3], b[cb][j], acc, 0, 0, 0);
    }
    const float sc = ps[g * 256 + d0 + r32];
    const int uc = g * 256 + d0 + r32;
    bf16_t* op = WT1 + (size_t)((uc >> 7) * 256 + (uc & 127)) * D + k0 + 4 * hi;
#pragma unroll
    for (int q = 0; q < 4; ++q) { u32x2 o; o.x = cvt_pk_bf16(acc[4 * q + 0] * sc, acc[4 * q + 1] * sc); o.y = cvt_pk_bf16(acc[4 * q + 2] * sc, acc[4 * q + 3] * sc); *(u32x2*)(op + 8 * q) = o; }
}
__device__ __forceinline__ int even_dst_row(int s) {
    const int seg = s >> 10, ch = s & 1023;
    if (seg == 4) return (ch >> 7) * 256 + 128 + (ch & 127);
    const int q = (seg == 2) ? 0 : (seg == 3) ? 1 : (seg == 1) ? 2 : 3;
    return (8 + (ch >> 6)) * 256 + 128 * (q >> 1) + 32 * ((ch >> 4) & 3) + 8 * ((ch >> 2) & 3) + 4 * (q & 1) + (ch & 3);
}
__device__ const float INVF[8] = {1.0f, 0.19392274474868576f, 0.03760603093086393f, 0.007292664737217109f, 0.001414213562373095f, 0.0002742481756762073f, 5.318295896944988e-05f, 1.031338537721246e-05f};

struct Args { const void* in[14]; float* out; unsigned char* ws; int ph_lo, ph_hi, rep_mask, pad; };

__device__ __forceinline__ void unpack8(const u32x4 w, float (&f)[8]) {
    f[0] = bf_lo(w.x); f[1] = bf_hi(w.x); f[2] = bf_lo(w.y); f[3] = bf_hi(w.y); f[4] = bf_lo(w.z); f[5] = bf_hi(w.z); f[6] = bf_lo(w.w); f[7] = bf_hi(w.w);
}
__device__ __forceinline__ u32x4 pack8(const float (&f)[8]) {
    u32x4 w; w.x = cvt_pk_bf16(f[0], f[1]); w.y = cvt_pk_bf16(f[2], f[3]); w.z = cvt_pk_bf16(f[4], f[5]); w.w = cvt_pk_bf16(f[6], f[7]); return w;
}
constexpr int RUN = 32, NRUN = M / RUN, NCH = 128;
template <int W> __device__ __forceinline__ void p2_pool_item(bf16_t* OUT, const bf16_t* U0, const bf16_t* Z0, const bf16_t* UT, int blk, int c0) {
    const bool first = ((blk * 128) % SEQ) == 0;
    const bf16_t* u0 = U0 + (size_t)blk * 15 * 1024 + c0; const bf16_t* z0 = Z0 + (size_t)blk * 15 * 1024 + c0;
    const bf16_t* ut = UT + ((size_t)blk * 15 - 15) * 1024 + c0;
    u32x4 lu[15], lz[5], lt[W - 1];
#pragma unroll
    for (int t = 0; t < 15; ++t) lu[t] = __builtin_nontemporal_load((const u32x4*)(u0 + (size_t)t * 1024));
#pragma unroll
    for (int k = 1; k < W; ++k) lt[k - 1] = first ? (u32x4){0u, 0u, 0u, 0u} : __builtin_nontemporal_load((const u32x4*)(ut + (size_t)(15 - k) * 1024));
    float sum[8];
#pragma unroll
    for (int e = 0; e < 8; ++e) sum[e] = 0.f;
#pragma unroll
    for (int k = 1; k < W; ++k) { float f[8]; unpack8(lt[k - 1], f);
#pragma unroll
        for (int e = 0; e < 8; ++e) sum[e] += f[e]; }
#pragma unroll
    for (int t = 0; t < 15; ++t) {
        if (t % 5 == 0) {
#pragma unroll
            for (int q = 0; q < 5; ++q) lz[q] = __builtin_nontemporal_load((const u32x4*)(z0 + (size_t)(t + q) * 1024)); }
        float cur[8], sz[8], o[8]; unpack8(lu[t], cur); unpack8(lz[t % 5], sz);
        const int cnt = first ? ((t + 1 < W) ? (t + 1) : W) : W; const float inv = 1.0f / (float)cnt;
#pragma unroll
        for (int e = 0; e < 8; ++e) { sum[e] += cur[e]; o[e] = (sum[e] * inv - cur[e]) * sz[e]; }
        *(u32x4*)(OUT + (size_t)(blk * 128 + t) * EVEN_W + c0) = pack8(o);
        const int idx = t - W + 1;
        float old[8];
        if (idx >= 0) unpack8(lu[idx >= 0 ? idx : 0], old); else unpack8(lt[(-idx - 1) < (W - 1) ? (-idx - 1) : 0], old);
#pragma unroll
        for (int e = 0; e < 8; ++e) sum[e] -= old[e];
    }
}
__device__ __forceinline__ void p2_phase(bf16_t* OUT, const bf16_t* CUS, const bf16_t* GZS, const bf16_t* U0, const bf16_t* Z0, const bf16_t* UT, const float* conv_w, int gtid, int gthreads) {
    for (int it = gtid; it < (M / 128) * NCH; it += gthreads) {
        const int blk = it / NCH, chunk = it % NCH, c0 = chunk * 8;
        switch (chunk >> 5) { case 0: p2_pool_item<2>(OUT, U0, Z0, UT, blk, c0); break; case 1: p2_pool_item<4>(OUT, U0, Z0, UT, blk, c0); break;
                              case 2: p2_pool_item<8>(OUT, U0, Z0, UT, blk, c0); break; default: p2_pool_item<16>(OUT, U0, Z0, UT, blk, c0); break; }
    }
    for (int it = gtid; it < (M / 64) * NCH; it += gthreads) {
        const int grp = it / NCH, c0 = (it % NCH) * 8; const bool first = ((grp * 64) % SEQ) == 0;
        float cw0[8], cw1[8], cw2[8], cu0[8], cu1[8], pm1[8], pm2[8], gz0[8], gz1[8], o0[8], o1[8];
#pragma unroll
        for (int e = 0; e < 8; ++e) { cw0[e] = conv_w[c0 + e]; cw1[e] = conv_w[1024 + c0 + e]; cw2[e] = conv_w[2048 + c0 + e]; pm1[e] = 0.f; pm2[e] = 0.f; }
        unpack8(__builtin_nontemporal_load((const u32x4*)(CUS + (size_t)(grp * 4 + 0) * 1024 + c0)), cu0); unpack8(__builtin_nontemporal_load((const u32x4*)(CUS + (size_t)(grp * 4 + 1) * 1024 + c0)), cu1);
        unpack8(__builtin_nontemporal_load((const u32x4*)(GZS + (size_t)(grp * 2 + 0) * 1024 + c0)), gz0); unpack8(__builtin_nontemporal_load((const u32x4*)(GZS + (size_t)(grp * 2 + 1) * 1024 + c0)), gz1);
        if (!first) { unpack8(__builtin_nontemporal_load((const u32x4*)(CUS + (size_t)((grp - 1) * 4 + 3) * 1024 + c0)), pm1); unpack8(__builtin_nontemporal_load((const u32x4*)(CUS + (size_t)((grp - 1) * 4 + 2) * 1024 + c0)), pm2); }
#pragma unroll
        for (int e = 0; e < 8; ++e) { o0[e] = gz0[e] * (cw2[e] * cu0[e] + cw1[e] * pm1[e] + cw0[e] * pm2[e]); o1[e] = gz1[e] * (cw2[e] * cu1[e] + cw1[e] * cu0[e] + cw0[e] * pm1[e]); }
        *(u32x4*)(OUT + (size_t)(grp * 64) * EVEN_W + 1024 + c0) = pack8(o0); *(u32x4*)(OUT + (size_t)(grp * 64 + 1) * EVEN_W + 1024 + c0) = pack8(o1);
    }
}

__device__ __forceinline__ int crow(int r, int hi) { return (r & 3) + 8 * (r >> 2) + 4 * hi; }
constexpr int KS_STRIDE = 72, VT_STRIDE = 260, VT_OFF = 256 * KS_STRIDE * 2, ATT_WB_OFF = 70656;
static_assert(VT_OFF + 64 * VT_STRIDE * 2 <= ATT_WB_OFF && ATT_WB_OFF + 8 * 32 * KS_STRIDE * 2 <= 131072, "attention LDS map");
__device__ __forceinline__ void attn_phase(LAS unsigned char* lds, const bf16_t* P1, bf16_t* ATT, const float* sinks, int vcu, int G) {
    int tid = threadIdx.x; asm volatile("" : "+v"(tid));
    const int lane = tid & 63, wid = __builtin_amdgcn_readfirstlane(tid >> 6), r32 = lane & 31, hi = lane >> 5;
    LAS bf16_t* Ks = (LAS bf16_t*)lds;
    LAS bf16_t* Vt = (LAS bf16_t*)(lds + VT_OFF);
    LAS bf16_t* wb = (LAS bf16_t*)(lds + ATT_WB_OFF) + wid * (32 * KS_STRIDE);
    const int crow_ = lane >> 3, cpc = (lane & 7) * 8;
    constexpr int NU = (M / 128) * 2;
    u32x4 kvr[4], vvr[4];
#define ATT_LOAD_KV(unit_) do { const int kh_ = (unit_) & 1, blk_ = (unit_) >> 1, n_ = blk_ & 63; const unsigned R0_ = (unsigned)blk_ * 128u; \
        _Pragma("unroll") for (int i = 0; i < 4; ++i) { const int p = tid + 512 * i, key = p >> 3, ch = p & 7; \
            kvr[i] = (u32x4){0u, 0u, 0u, 0u}; vvr[i] = (u32x4){0u, 0u, 0u, 0u}; \
            if ((n_ > 0) || (key >= 128)) { const bf16_t* rp = P1 + ((R0_ + (unsigned)key - 128u) * (unsigned)ODD_IN + (unsigned)(kh_ * 64 + ch * 8)); kvr[i] = __builtin_nontemporal_load((const u32x4*)(rp + 1024)); vvr[i] = __builtin_nontemporal_load((const u32x4*)(rp + 1152)); } } } while (0)
    int unit = vcu;
    if (unit < NU) ATT_LOAD_KV(unit);
    for (; unit < NU; unit += G) {
        const int kh = unit & 1, blk = unit >> 1, n = blk & 63;
        const unsigned R0 = (unsigned)blk * 128u;
        __syncthreads();
#pragma unroll
        for (int i = 0; i < 4; ++i) {
            const int p = tid + 512 * i, key = p >> 3, ch = p & 7;
            const u32x4 kv = kvr[i], vv = vvr[i];
            *(LAS u32x4*)(Ks + key * KS_STRIDE + ch * 8) = kv;
            LAS bf16_t* vp = Vt + (ch * 8) * VT_STRIDE + key;
            vp[0 * VT_STRIDE] = (bf16_t)(vv.x & 0xffffu); vp[1 * VT_STRIDE] = (bf16_t)(vv.x >> 16);
            vp[2 * VT_STRIDE] = (bf16_t)(vv.y & 0xffffu); vp[3 * VT_STRIDE] = (bf16_t)(vv.y >> 16);
            vp[4 * VT_STRIDE] = (bf16_t)(vv.z & 0xffffu); vp[5 * VT_STRIDE] = (bf16_t)(vv.z >> 16);
            vp[6 * VT_STRIDE] = (bf16_t)(vv.w & 0xffffu); vp[7 * VT_STRIDE] = (bf16_t)(vv.w >> 16);
        }
        __syncthreads();
        if (unit + G < NU) ATT_LOAD_KV(unit + G);
        const int h = kh * 8 + wid;
        const float sink2 = sinks[h] * LOG2E;
        u32x4 qn[4], gn[4];
#define ATT_LOAD_QG(c_) do { const unsigned tk_ = R0 + 32u * (unsigned)(c_) + (unsigned)crow_; const bf16_t* qp_ = P1 + (tk_ * (unsigned)ODD_IN + (unsigned)(h * 64 + cpc)); \
        _Pragma("unroll") for (int i = 0; i < 4; ++i) { qn[i] = __builtin_nontemporal_load((const u32x4*)(qp_ + (unsigned)(8 * i) * (unsigned)ODD_IN)); gn[i] = __builtin_nontemporal_load((const u32x4*)(qp_ + (unsigned)(8 * i) * (unsigned)ODD_IN + 1280)); } } while (0)
        ATT_LOAD_QG(0);
        for (int c = 0; c < 4; ++c) {
            bf16x8 qf[4]; u32x2 gz[2][4];
#pragma unroll
            for (int i = 0; i < 4; ++i) *(LAS u32x4*)(wb + (crow_ + 8 * i) * KS_STRIDE + cpc) = qn[i];
#pragma unroll
            for (int d0 = 0; d0 < 4; ++d0) qf[d0] = *(const LAS bf16x8*)(wb + r32 * KS_STRIDE + d0 * 16 + hi * 8);
            asm volatile("s_waitcnt lgkmcnt(0)" ::: "memory");
#pragma unroll
            for (int i = 0; i < 4; ++i) *(LAS u32x4*)(wb + (crow_ + 8 * i) * KS_STRIDE + cpc) = gn[i];
#pragma unroll
            for (int dt = 0; dt < 2; ++dt)
#pragma unroll
                for (int g4 = 0; g4 < 4; ++g4) gz[dt][g4] = *(const LAS u32x2*)(wb + r32 * KS_STRIDE + 32 * dt + 8 * g4 + 4 * hi);
            asm volatile("s_waitcnt lgkmcnt(0)" ::: "memory");
            if (c < 3) ATT_LOAD_QG(c + 1);
            f32x16 st[5];
#pragma unroll
            for (int kt = 0; kt < 5; ++kt) {
                f32x16 a; const float a0 = ((n == 0) && (c + kt < 4)) ? -INFINITY : 0.f;
#pragma unroll
                for (int r = 0; r < 16; ++r) a[r] = a0;
#pragma unroll
                for (int d0 = 0; d0 < 4; ++d0) { const bf16x8 kf = *(const LAS bf16x8*)(Ks + (32 * (c + kt) + r32) * KS_STRIDE + d0 * 16 + hi * 8);
                    a = __builtin_amdgcn_mfma_f32_32x32x16_bf16(kf, qf[d0], a, 0, 0, 0); }
                st[kt] = a;
            }
            float mx = sink2;
#pragma unroll
            for (int kt = 0; kt < 5; ++kt)
#pragma unroll
                for (int r = 0; r < 16; ++r) { const int dd = 32 * kt + crow(r, hi) - r32;
                    float s_ = st[kt][r];
                    if (kt == 0) s_ = (dd >= 1) ? s_ : -INFINITY;
                    if (kt == 4) s_ = (dd <= 128) ? s_ : -INFINITY;
                    st[kt][r] = s_; }
            { float ma = mx, mb = mx;
#pragma unroll
              for (int kt = 0; kt < 5; ++kt)
#pragma unroll
                  for (int r = 0; r < 16; r += 4) { ma = __builtin_fmaxf(__builtin_fmaxf(ma, st[kt][r]), st[kt][r + 1]); mb = __builtin_fmaxf(__builtin_fmaxf(mb, st[kt][r + 2]), st[kt][r + 3]); }
              mx = __builtin_fmaxf(ma, mb); }
            mx = fmaxf(mx, __shfl_xor(mx, 32));
            float l = 0.f;
#pragma unroll
            for (int kt = 0; kt < 5; ++kt)
#pragma unroll
                for (int r = 0; r < 16; ++r) { const float p = __builtin_amdgcn_exp2f(st[kt][r] - mx); st[kt][r] = p; l += p; }
            l += __shfl_xor(l, 32);
            l += __builtin_amdgcn_exp2f(sink2 - mx);
            f32x16 o[2];
#pragma unroll
            for (int r = 0; r < 16; ++r) { o[0][r] = 0.f; o[1][r] = 0.f; }
#pragma unroll
            for (int kt = 0; kt < 5; ++kt)
#pragma unroll
                for (int s_ = 0; s_ < 2; ++s_) {
                    u32x4 pw; pw.x = cvt_pk_bf16(st[kt][8 * s_ + 0], st[kt][8 * s_ + 1]); pw.y = cvt_pk_bf16(st[kt][8 * s_ + 2], st[kt][8 * s_ + 3]);
                    pw.z = cvt_pk_bf16(st[kt][8 * s_ + 4], st[kt][8 * s_ + 5]); pw.w = cvt_pk_bf16(st[kt][8 * s_ + 6], st[kt][8 * s_ + 7]);
                    const bf16x8 pf = __builtin_bit_cast(bf16x8, pw);
#pragma unroll
                    for (int dt = 0; dt < 2; ++dt) {
                        const LAS bf16_t* vp = Vt + (32 * dt + r32) * VT_STRIDE + 32 * (c + kt) + 16 * s_ + 4 * hi;
                        const s16x4 lo = *(const LAS s16x4*)vp, hi4 = *(const LAS s16x4*)(vp + 8);
                        const bf16x8 vf = (bf16x8){lo[0], lo[1], lo[2], lo[3], hi4[0], hi4[1], hi4[2], hi4[3]};
                        o[dt] = __builtin_amdgcn_mfma_f32_32x32x16_bf16(vf, pf, o[dt], 0, 0, 0);
                    }
                }
            const float rl = 1.0f / l;
#pragma unroll
            for (int dt = 0; dt < 2; ++dt)
#pragma unroll
                for (int g4 = 0; g4 < 4; ++g4) {
                    const u32x2 gzz = gz[dt][g4];
                    u32x2 w; w.x = cvt_pk_bf16(o[dt][4 * g4 + 0] * rl * bf_lo(gzz.x), o[dt][4 * g4 + 1] * rl * bf_hi(gzz.x));
                    w.y = cvt_pk_bf16(o[dt][4 * g4 + 2] * rl * bf_lo(gzz.y), o[dt][4 * g4 + 3] * rl * bf_hi(gzz.y));
                    *(LAS u32x2*)(wb + r32 * KS_STRIDE + 32 * dt + 8 * g4 + 4 * hi) = w;
                }
            asm volatile("s_waitcnt lgkmcnt(0)" ::: "memory");
            { bf16_t* op = ATT + ((R0 + 32u * (unsigned)c + (unsigned)crow_) * (unsigned)D + (unsigned)(h * 64 + cpc));
#pragma unroll
              for (int i = 0; i < 4; ++i) { const u32x4 v_ = *(const LAS u32x4*)(wb + (crow_ + 8 * i) * KS_STRIDE + cpc); *(u32x4*)(op + (unsigned)(8 * i) * (unsigned)D) = v_; } }
            asm volatile("s_waitcnt lgkmcnt(0)" ::: "memory");
        }
#undef ATT_LOAD_QG
    }
#undef ATT_LOAD_KV
}

#define XB_TMO      128
#define XB_XCNT(j)  (256  + 64 * (j))
#define XB_XSUB(j)  (1280 + 64 * (j))
#define XB_XGEN(j)  (2304 + 64 * (j))
#define XB_TOP      3328
#define XB_TOPGEN   3392
#define XCD_BAR_WORDS 3456
#define XB_SPIN_CAP (1u << 22)
__device__ __forceinline__ unsigned xb_ld(unsigned* p)              { return __hip_atomic_load(p, __ATOMIC_RELAXED, __HIP_MEMORY_SCOPE_AGENT); }
__device__ __forceinline__ unsigned xb_add(unsigned* p, unsigned v) { return __hip_atomic_fetch_add(p, v, __ATOMIC_RELAXED, __HIP_MEMORY_SCOPE_AGENT); }
__device__ __forceinline__ unsigned xb_xcc_id() { return (unsigned)__builtin_amdgcn_s_getreg((3 << 11) | 20) & 0xFu; }
#define XB_SPIN(cond, bar) do { unsigned _sp = 0; while (cond) { __builtin_amdgcn_s_sleep(1); \
    if ((++_sp & 255u) == 0u) { if (xb_ld(&(bar)[XB_TMO])) break; if (_sp > XB_SPIN_CAP) { atomicAdd(&(bar)[XB_TMO], 1u); break; } } } } while (0)
#define XB_EXIT     3400
__device__ unsigned g_barrier_words[XCD_BAR_WORDS];
__device__ unsigned g_panel_cnt[128 * 16];
struct XcdBarrier { unsigned* bar; unsigned x; volatile LAS unsigned* st; };
__device__ __forceinline__ XcdBarrier xcd_barrier_post(unsigned* bar, volatile LAS unsigned* st) {
    XcdBarrier b; b.bar = bar; b.x = xb_xcc_id(); b.st = st;
    if (threadIdx.x == 0) (void)xb_add(&bar[XB_XCNT(b.x)], 1u);
    return b;
}
__device__ __forceinline__ void xcd_barrier_complete(unsigned* bar, unsigned x, unsigned& nloc, unsigned& nx) {
    const unsigned G = gridDim.x * gridDim.y * gridDim.z;
    unsigned sum, cnt, mine, sp = 0u;
    for (;;) {
        sum = 0u; cnt = 0u; mine = 0u;
#pragma unroll
        for (unsigned j = 0; j < 16; ++j) { const unsigned c = xb_ld(&bar[XB_XCNT(j)]); sum += c; cnt += (c > 0u) ? 1u : 0u; mine = (j == x) ? c : mine; }
        if (sum == G) break;
        __builtin_amdgcn_s_sleep(1);
        if ((++sp & 255u) == 0u) { if (xb_ld(&bar[XB_TMO])) break; if (sp > XB_SPIN_CAP) { atomicAdd(&bar[XB_TMO], 1u); break; } }
    }
    nloc = mine > 0u ? mine : 1u; nx = cnt > 0u ? cnt : 1u;
}
__device__ __forceinline__ void xcd_barrier(const XcdBarrier& b) {
    asm volatile("s_waitcnt vmcnt(0)" ::: "memory");
    __syncthreads();
    if (threadIdx.x == 0) {
        unsigned* bar = b.bar;
        __builtin_amdgcn_s_waitcnt(0);
        unsigned nloc = b.st[0], nx = b.st[1];
        if (nloc == 0u) { xcd_barrier_complete(bar, b.x, nloc, nx); b.st[0] = nloc; b.st[1] = nx; }
        const unsigned old = xb_add(&bar[XB_XSUB(b.x)], 1u);
        const unsigned gen = old / nloc;
        if (old + 1u == (gen + 1u) * nloc) {
            __builtin_amdgcn_fence(__ATOMIC_RELEASE, "agent");
            asm volatile("s_waitcnt vmcnt(0)" ::: "memory");
            const unsigned og = xb_add(&bar[XB_TOP], 1u);
            const unsigned tg = og / nx;
            if (og + 1u == (tg + 1u) * nx) xb_add(&bar[XB_TOPGEN], 1u);
            else XB_SPIN(xb_ld(&bar[XB_TOPGEN]) == tg, bar);
            __builtin_amdgcn_fence(__ATOMIC_ACQUIRE, "agent");
            xb_add(&bar[XB_XGEN(b.x)], 1u);
            asm volatile("s_waitcnt vmcnt(0)" ::: "memory");
        } else {
            XB_SPIN(xb_ld(&bar[XB_XGEN(b.x)]) == gen, bar);
            __builtin_amdgcn_fence(__ATOMIC_ACQUIRE, "agent");
            asm volatile("s_waitcnt vmcnt(0)" ::: "memory");
        }
    }
    __syncthreads();
}

constexpr int RSTD_OFF = 131072 + 1024;
constexpr int LDS_BYTES = 131072 + 1024 + 5 * 256 * 4 + 64;
__global__ void __launch_bounds__(512, 2) fwd_megakernel(Args a) {
    __builtin_assume(__builtin_amdgcn_workitem_id_y() == 0); __builtin_assume(__builtin_amdgcn_workitem_id_z() == 0);
    extern __shared__ __attribute__((aligned(16))) unsigned char lds_raw[];
    LAS unsigned char* lds = (LAS unsigned char*)lds_raw;
    cg::grid_group grid = cg::this_grid();
#define FRESH_TID(tid, lane, wave) int tid = threadIdx.x; asm volatile("" : "+v"(tid)); const int lane = tid & 63, wave = __builtin_amdgcn_readfirstlane(tid >> 6); (void)lane; (void)wave
    const int G = gridDim.x, bx = blockIdx.x;
    const int vcu = (G % 8 == 0) ? (bx % 8) * (G / 8) + bx / 8 : bx;
    const float* x = (const float*)a.in[0]; const int* pos = (const int*)a.in[1]; const float* norm_g = (const float*)a.in[2];
    const float* w_in_even = (const float*)a.in[3]; const float* w_pool = (const float*)a.in[4]; const float* pool_scale = (const float*)a.in[5];
    const float* conv_w = (const float*)a.in[6]; const float* w_out_even = (const float*)a.in[7]; const float* w_in_odd = (const float*)a.in[8];
    const float* b_in_odd = (const float*)a.in[9]; const float* sinks = (const float*)a.in[10]; const float* w_out_odd = (const float*)a.in[11];
    const float* b_out_odd = (const float*)a.in[12]; const float* final_g = (const float*)a.in[13];
    unsigned char* ws = a.ws;
    float* SS1 = (float*)(ws + WS_SS1); float* SS2 = (float*)(ws + WS_SS2); float* COS = (float*)(ws + WS_COS);
    bf16_t* WT1 = (bf16_t*)(ws + WS_WT1); bf16_t* WT2 = (bf16_t*)(ws + WS_WT2); bf16_t* WT3 = (bf16_t*)(ws + WS_WT3); bf16_t* WT4 = (bf16_t*)(ws + WS_WT4);
    bf16_t* XN = (bf16_t*)(ws + WS_XN); bf16_t* PROJ1 = (bf16_t*)(ws + WS_PROJ1); bf16_t* ATT = (bf16_t*)(ws + WS_ATT); bf16_t* CUS = (bf16_t*)(ws + WS_CUS); bf16_t* GZS = (bf16_t*)(ws + WS_GZS); bf16_t* U0 = (bf16_t*)(ws + WS_U0); bf16_t* Z0 = (bf16_t*)(ws + WS_Z0); bf16_t* UT = (bf16_t*)(ws + WS_UT);
    bf16_t* OUTB = (bf16_t*)a.out;
    const int lo = a.ph_lo, hi = a.ph_hi;
    volatile LAS unsigned* MISC = (volatile LAS unsigned*)(lds + 131072);
    if (threadIdx.x < 16) MISC[threadIdx.x] = 0u;
    __syncthreads();
    XcdBarrier bar; bar.bar = g_barrier_words; bar.x = 0; bar.st = MISC;
    if (hi - lo > 1) bar = xcd_barrier_post(g_barrier_words, MISC);
#define IN(k) (lo <= (k) && (k) < hi)
#define REP(k) for (int rep_ = 0; rep_ < (((a.rep_mask >> (k)) & 1) ? 2 : 1); ++rep_)
#define SEAM(k) do { if (IN(k) && IN((k) + 1)) xcd_barrier(bar); } while (0)

    if ((a.rep_mask >> 9) & 1) { for (int i_ = 0; i_ < 16; ++i_) grid.sync(); }
    if ((a.rep_mask >> 10) & 1) { for (int i_ = 0; i_ < 16; ++i_) xcd_barrier(bar); }
    if (IN(0)) REP(0) {
        FRESH_TID(tid, lane, wave);
        LAS float* scr = (LAS float*)(lds + wave * 16384);
        const int gw = vcu * 8 + wave, NGW = G * 8;
        constexpr int IF = 4 * 32 * 8;
        constexpr int NB1 = (EVEN_IN - 1024) / 32, I1 = (D / 64) * NB1;
        constexpr int NB2 = D / 32, I2 = (EVEN_W / 64) * NB2, NB3 = ODD_IN / 32, I3 = (D / 64) * NB3, NB4 = D / 32, I4 = (D / 64) * NB4;
        constexpr int NITEMS = IF + I1 + I2 + I3 + I4;
        for (int it = gw; it < NITEMS; it += NGW) {
            int r = it;
            if (r < IF) { p0_fold_item(w_in_even, w_pool, pool_scale, WT1, r, lane); continue; } r -= IF;
            if (r < I1) { const int n0 = 1024 + (r % NB1) * 32; p0_transpose_item(w_in_even, D, EVEN_IN, WT1, 0, scr, 64 * (r / NB1), n0, lane, nullptr, true); continue; } r -= I1;
            if (r < I2) { p0_transpose_item(w_out_even, EVEN_W, D, WT2, 0, scr, 64 * (r / NB2), 32 * (r % NB2), lane); continue; } r -= I2;
            if (r < I3) { p0_transpose_item(w_in_odd, D, ODD_IN, WT3, 0, scr, 64 * (r / NB3), 32 * (r % NB3), lane, norm_g + D); continue; } r -= I3;
            p0_transpose_item(w_out_odd, D, D, WT4, 0, scr, 64 * (r / NB4), 32 * (r % NB4), lane);
        }
        f32x4 gq[4];
#pragma unroll
        for (int j = 0; j < 4; ++j) gq[j] = *((const f32x4*)norm_g + lane + 64 * j);
        for (int mb = gw; mb < M; mb += 4 * NGW) {
            f32x4 v[4][4]; float sq[4];
#pragma unroll
            for (int q = 0; q < 4; ++q) { const f32x4* xr = (const f32x4*)(x + (size_t)(mb + q * NGW) * D) + lane;
#pragma unroll
                for (int j = 0; j < 4; ++j) v[q][j] = __builtin_nontemporal_load(xr + 64 * j); }
#pragma unroll
            for (int q = 0; q < 4; ++q) { float s_ = 0.f;
#pragma unroll
                for (int j = 0; j < 4; ++j) s_ += (v[q][j].x * v[q][j].x + v[q][j].y * v[q][j].y) + (v[q][j].z * v[q][j].z + v[q][j].w * v[q][j].w);
                sq[q] = s_; }
#pragma unroll
            for (int o = 1; o < 64; o <<= 1) {
#pragma unroll
                for (int q = 0; q < 4; ++q) sq[q] += __shfl_xor(sq[q], o); }
#pragma unroll
            for (int q = 0; q < 4; ++q) { const float ms = sq[q] * (1.f / D) + EPS; const float rstd = rsqrtf(ms);
                if (lane == 0) COS  [mb + q * NGW] = sqrtf(ms);
                u32x2* o8 = (u32x2*)(XN + (size_t)(mb + q * NGW) * D) + lane;
#pragma unroll
                for (int j = 0; j < 4; ++j) { u32x2 w; w.x = cvt_pk_bf16(v[q][j].x * rstd * gq[j].x, v[q][j].y * rstd * gq[j].y); w.y = cvt_pk_bf16(v[q][j].z * rstd * gq[j].z, v[q][j].w * rstd * gq[j].w); o8[64 * j] = w; } }
        }
        { float* ropec = (float*)(ws + WS_ROPEC); float* ropes = (float*)(ws + WS_ROPES);
          for (int idx = vcu * 512 + tid; idx < M * 8; idx += G * 512) {
              const float ang = (float)pos[idx >> 3] * INVF[idx & 7]; const float fr_ = __builtin_amdgcn_fractf(ang * 0.15915494309189535f);
              ropec[idx] = __builtin_amdgcn_cosf(fr_); ropes[idx] = __builtin_amdgcn_sinf(fr_); } }
        __syncthreads();
    }
    SEAM(0);
    if (IN(1)) REP(1) {
        pg8::Gemm g{XN, WT1, M, EVEN_IN, D, 0}; pg8::StaticOrder S; S.init(M, EVEN_IN, G, bx);
        pg8::EpiEven E{OUTB, CUS, GZS, U0, Z0, UT, conv_w};
        pg8::gemm_phase<pg8::EpiEven, true>(lds, g, S, E);
    }
    SEAM(1);
    if (IN(2)) REP(2) { FRESH_TID(tid, lane, wave); p2_phase(OUTB, CUS, GZS, U0, Z0, UT, conv_w, vcu * 512 + tid, G * 512); }
    if (IN(2) && IN(4)) xcd_barrier(bar);
    if (IN(4)) REP(4) {
        pg8::Gemm g{OUTB, WT2, M, D, EVEN_W, 0}; pg8::StaticOrder S; S.init(M, D, G, bx);
        pg8::EpiRes1 E{XN  , COS  , norm_g, SS1};
        pg8::gemm_phase(lds, g, S, E);
    }
    SEAM(4);
    if (IN(5)) REP(5) {
        pg8::Gemm g{XN, WT3, M, ODD_IN, D, 0}; pg8::StaticOrder S; S.init(M, ODD_IN, G, bx); if (G == 256) S.tail_round = 4;
        LAS float* rtab = (LAS float*)(lds + RSTD_OFF);
        { FRESH_TID(tid, lane, wave);
          for (int i = tid >> 8; i < 5; i += 2) { pg8::Unit u; if (!S.next(i, u)) break;
              const float* sp = SS1 + (size_t)(u.pm * 256 + (tid & 255)) * 16;
              const f32x4 s0 = *(const f32x4*)sp, s1 = *(const f32x4*)(sp + 4), s2 = *(const f32x4*)(sp + 8), s3 = *(const f32x4*)(sp + 12);
              const float tot = ((s0[0] + s0[1]) + (s0[2] + s0[3])) + ((s1[0] + s1[1]) + (s1[2] + s1[3])) + ((s2[0] + s2[1]) + (s2[2] + s2[3])) + ((s3[0] + s3[1]) + (s3[2] + s3[3]));
              rtab[i * 256 + (tid & 255)] = rsqrtf(tot * (1.0f / D) + EPS); }
          __syncthreads(); }
        pg8::EpiQKVZ E{PROJ1, b_in_odd, (const float*)(ws + WS_ROPEC), (const float*)(ws + WS_ROPES), rtab};
        pg8::gemm_phase<pg8::EpiQKVZ, false, true>(lds, g, S, E);
    }
    SEAM(5);
    if (IN(6)) REP(6) { attn_phase(lds, PROJ1, ATT, sinks, vcu, G); __syncthreads(); }
    SEAM(6);
    if (IN(7)) REP(7) {
        pg8::Gemm g{ATT, WT4, M, D, D, 0}; pg8::StaticOrder S; S.init(M, D, G, bx);
        pg8::EpiFinal E{XN  , a.out, b_out_odd, final_g, SS2  , g_panel_cnt, lds + RSTD_OFF};
        pg8::gemm_phase(lds, g, S, E);
    }
    if (hi - lo > 1) {
        __syncthreads();
        if (threadIdx.x == 0) { const unsigned old = xb_add(&g_barrier_words[XB_EXIT], 1u); MISC[4] = (old + 1u == (unsigned)gridDim.x) ? 1u : 0u; }
        __syncthreads();
        if (MISC[4] != 0u) {
            for (int i_ = threadIdx.x; i_ < XCD_BAR_WORDS; i_ += 512) __hip_atomic_store(&g_barrier_words[i_], 0u, __ATOMIC_RELAXED, __HIP_MEMORY_SCOPE_AGENT);
            for (int i_ = threadIdx.x; i_ < 128 * 16; i_ += 512) __hip_atomic_store(&g_panel_cnt[i_], 0u, __ATOMIC_RELAXED, __HIP_MEMORY_SCOPE_AGENT);
            __builtin_amdgcn_fence(__ATOMIC_RELEASE, "agent");
        }
    }
#undef IN
#undef SEAM
}

extern "C" void kernel_launch(void* const* d_in, const int* in_sizes, int n_in, void* d_out, int out_size, void* d_ws, size_t ws_size, hipStream_t stream) {
    static int grid = 0;
    if (grid == 0) {
        if (n_in != 14 || in_sizes[0] != M * D || out_size != M * D || ws_size < WS_END) {
            fprintf(stderr, "kernel_launch: shape/workspace mismatch (n_in %d, in0 %d, out %d, ws %zu); nothing launched\n", n_in, n_in > 0 ? in_sizes[0] : -1, out_size, ws_size); grid = -1; return; }
        int dev = 0, cus = 0, per_cu = 0;
        if (hipGetDevice(&dev) != hipSuccess || hipDeviceGetAttribute(&cus, hipDeviceAttributeMultiprocessorCount, dev) != hipSuccess) { grid = -1; return; }
        if (hipFuncSetAttribute((const void*)fwd_megakernel, hipFuncAttributeMaxDynamicSharedMemorySize, LDS_BYTES) != hipSuccess) { fprintf(stderr, "kernel_launch: hipFuncSetAttribute failed\n"); grid = -1; return; }
        if (hipOccupancyMaxActiveBlocksPerMultiprocessor(&per_cu, (const void*)fwd_megakernel, 512, LDS_BYTES) != hipSuccess || per_cu < 1) { fprintf(stderr, "kernel_launch: occupancy query says %d\n", per_cu); per_cu = 1; }
        (void)hipGetLastError();
        grid = cus * 1;
    }
    if (grid < 0) return;
    Args a{};
    for (int i = 0; i < 14; ++i) a.in[i] = d_in[i];
    a.out = (float*)d_out; a.ws = (unsigned char*)d_ws; a.rep_mask = PROBE_MASK;
#if MK_N_LAUNCHES == 1
    a.ph_lo = 0; a.ph_hi = 9;
    void* args[] = {&a};
    hipError_t e = hipLaunchCooperativeKernel((const void*)fwd_megakernel, dim3(grid), dim3(512), args, LDS_BYTES, stream);
    if (e != hipSuccess) fprintf(stderr, "cooperative launch failed: %s (grid %d)\n", hipGetErrorString(e), grid);
#else
    for (int p = 0; p < 9; ++p) { a.ph_lo = p; a.ph_hi = p + 1; hipLaunchKernelGGL(fwd_megakernel, dim3(grid), dim3(512), LDS_BYTES, stream, a); }
#endif
}
```

```cpp
#include <hip/hip_runtime.h>
#include <hip/hip_cooperative_groups.h>
#include <cstdio>
#include <cstdint>
#include <cmath>
namespace cg = cooperative_groups;

#ifndef PROBE_MASK
#define PROBE_MASK 0
#endif
#ifndef MK_N_LAUNCHES
#define MK_N_LAUNCHES 1
#endif

#define LAS __attribute__((address_space(3)))
#define GAS __attribute__((address_space(1)))
typedef unsigned short bf16_t;
typedef short bf16x8 __attribute__((ext_vector_type(8)));
typedef short s16x4 __attribute__((ext_vector_type(4)));
typedef float f32x4 __attribute__((ext_vector_type(4)));
typedef float f32x16 __attribute__((ext_vector_type(16)));
typedef unsigned u32x4 __attribute__((ext_vector_type(4)));
typedef unsigned u32x2 __attribute__((ext_vector_type(2)));

constexpr int BATCH = 4, SEQ = 8192, D = 1024, M = BATCH * SEQ;
constexpr int EVEN_IN = 6144, EVEN_W = 2048, ODD_IN = 2304;
constexpr int NHEAD = 16, HD = 64;
constexpr float EPS = 1e-5f;
constexpr float LOG2E = 1.4426950408889634f;
constexpr float C2 = 0.125f * LOG2E;

constexpr size_t MiB = 1u << 20;
constexpr size_t WS_SS1 = 0;
constexpr size_t WS_SS2 = 2 * MiB;
constexpr size_t WS_COS = 4 * MiB;
constexpr size_t WS_ROPEC = 5 * MiB, WS_ROPES = 6 * MiB;
constexpr size_t WS_WT1 = 8 * MiB, WS_WT2 = 21 * MiB, WS_WT3 = 25 * MiB, WS_WT4 = 30 * MiB;
constexpr size_t WS_XN = 32 * MiB;
constexpr size_t WS_PROJ1 = 96 * MiB;
constexpr size_t WS_ATT = 240 * MiB;
constexpr size_t WS_CUS = 368 * MiB;
constexpr size_t WS_GZS = 372 * MiB;
constexpr size_t WS_U0 = 376 * MiB;
constexpr size_t WS_Z0 = 384 * MiB;
constexpr size_t WS_UT = 392 * MiB;
constexpr size_t WS_END = 400 * MiB;

__device__ __forceinline__ unsigned cvt_pk_bf16(float lo, float hi) { unsigned r; asm volatile("v_cvt_pk_bf16_f32 %0, %1, %2" : "=v"(r) : "v"(lo), "v"(hi)); return r; }
__device__ __forceinline__ float bf_lo(unsigned w) { return __uint_as_float(w << 16); }
__device__ __forceinline__ float bf_hi(unsigned w) { return __uint_as_float(w & 0xffff0000u); }
__device__ __forceinline__ u32x4 pack8v(const float (&f)[8]) { u32x4 w; w.x = cvt_pk_bf16(f[0], f[1]); w.y = cvt_pk_bf16(f[2], f[3]); w.z = cvt_pk_bf16(f[4], f[5]); w.w = cvt_pk_bf16(f[6], f[7]); return w; }
__device__ __forceinline__ float silu_f(float z) { return z * __builtin_amdgcn_rcpf(1.0f + __builtin_amdgcn_exp2f(-LOG2E * z)); }

namespace pg8 {
constexpr int BM = 256, BK = 64, HALF = 128, HTB = HALF * BK * 2, STAGE_BYTES = 8 * HTB, NXCD = 8, WGM = 8;
__host__ __device__ __forceinline__ int lds_byte(int r, int c) { const int st = (r >> 4) * 2 + (c >> 5), rr = r & 15, cc = c & 31, ob = rr * 64 + cc * 2; return st * 1024 + (ob ^ (((ob >> 9) & 1) << 5)); }
__host__ __device__ __forceinline__ void stage_rc(int b, int& R, int& C) { const int st = b / 1024, sb = b % 1024, swz = sb ^ (((sb >> 9) & 1) << 5); R = (st >> 1) * 16 + swz / 64; C = (st & 1) * 32 + (swz % 64) / 2; }
__host__ __device__ __forceinline__ int perm32(int rho) { const int n = rho >> 4, i = rho & 15; return 8 * (i >> 2) + 4 * n + (i & 3); }

struct Unit { int pm, pn, idx, half; };
struct Gemm { const bf16_t* A; const bf16_t* Bt; int M, N, K; size_t a_pn_stride; };

struct StaticOrder {
    int nM, nN, nwg, G, c;
    __host__ __device__ void init(int M_, int N_, int G_, int c_) { nM = M_ / BM; nN = N_ / BM; nwg = nM * nN; G = G_; c = c_; }
    int tail_round = -1;
    __host__ __device__ bool next(int i, Unit& u) const {
        u.half = -1;
        int wgid;
        if (tail_round >= 0 && i >= tail_round) {
            if (i > tail_round) return false;
            const int xcd = c & 7, k = c >> 3;
            wgid = xcd * (nwg / NXCD) + tail_round * 32 + (k >> 1); u.half = k & 1;
        } else {
        const long L = (long)i * G + c; if (L >= nwg) return false;
        wgid = (int)L; { const int q = nwg / NXCD, r = nwg % NXCD, xcd = wgid % NXCD, off = wgid / NXCD; wgid = (xcd < r ? xcd * (q + 1) : r * (q + 1) + (xcd - r) * q) + off; }
        }
        const int nig = WGM * nN, gid = wgid / nig, fm = gid * WGM, gsz = (nM - fm) < WGM ? (nM - fm) : WGM;
        u.pm = fm + ((wgid % nig) % gsz); u.pn = (wgid % nig) / gsz; u.idx = i; return true;
    }
};

template <class Epi, bool RP = false, bool TS = false>
__device__ __forceinline__ void gemm_phase(LAS unsigned char* lds, const Gemm g, const StaticOrder& S, const Epi& E) {
    int tid = threadIdx.x; asm volatile("" : "+v"(tid));
    const int wid = __builtin_amdgcn_readfirstlane(tid >> 6), lane = tid & 63, wr = wid >> 2, wc = wid & 3, fr = lane & 15, fq = lane >> 4;
    const int K = g.K, nt = K / BK;
    unsigned voffA[2], voffB[2];
#pragma unroll
    for (int i = 0; i < 2; ++i) { int R, C; stage_rc(tid * 16 + i * 8192, R, C); const int Rb = (R & ~31) + perm32(R & 31); const int Ra = RP ? (128 * (R >> 6) + (R & 63)) : R;
        voffA[i] = (unsigned)(Ra * K + C) * 2u; voffB[i] = (unsigned)(Rb * K + C) * 2u; }
    const size_t kstep = (size_t)(BK * 2);
    const size_t hstep = (size_t)HALF * K * 2;
    const size_t tstep = 2 * hstep;
    const size_t hstepA = RP ? (size_t)64 * K * 2 : hstep;
    const unsigned ldsw = (unsigned)wid * 1024u;
    const int aoff = lds_byte(wr * 64 + fr, fq * 8), boff = lds_byte(wc * 32 + fr, fq * 8);
#define PG8_SA(b, h) (((b) * 2 + (h)) * HTB)
#define PG8_SB(b, h) ((4 + (b) * 2 + (h)) * HTB)
#define PG8_STAGE(bufoff, gbase, voff) do { _Pragma("unroll") for (int _i = 0; _i < 2; ++_i) \
        __builtin_amdgcn_global_load_lds((const unsigned*)((const char*)(gbase) + (voff)[_i]), (LAS unsigned*)(lds + (bufoff) + ldsw + _i * 8192), 16, 0, 0); } while (0)
#define PG8_LDA(dst, b, h) do { _Pragma("unroll") for (int m = 0; m < 4; ++m) _Pragma("unroll") for (int k = 0; k < 2; ++k) dst[m][k] = *(const LAS bf16x8*)(lds + PG8_SA(b, h) + aoff + m * 2048 + k * 1024); } while (0)
#define PG8_LDB(dst, b, h) do { _Pragma("unroll") for (int n = 0; n < 2; ++n) _Pragma("unroll") for (int k = 0; k < 2; ++k) dst[n][k] = *(const LAS bf16x8*)(lds + PG8_SB(b, h) + boff + n * 2048 + k * 1024); } while (0)
#define PG8_MMA(ai, bj, At, Bt) do { __builtin_amdgcn_s_setprio(1); _Pragma("unroll") for (int m = 0; m < 4; ++m) _Pragma("unroll") for (int n = 0; n < 2; ++n) _Pragma("unroll") for (int k = 0; k < 2; ++k) \
        acc[ai][bj][m][n] = __builtin_amdgcn_mfma_f32_16x16x32_bf16(Bt[n][k], At[m][k], acc[ai][bj][m][n], 0, 0, 0); __builtin_amdgcn_s_setprio(0); } while (0)
#define PG8_WAIT_V(n) asm volatile("s_waitcnt vmcnt(" #n ")" ::: "memory")
#define PG8_WAIT_L(n) asm volatile("s_waitcnt lgkmcnt(" #n ")" ::: "memory")
#define PG8_BAR __builtin_amdgcn_s_barrier()
#define PG8_SCHED __builtin_amdgcn_sched_barrier(0)
    Unit cur, nxt; int ui = 0;
    if (!S.next(0, cur)) return;
    f32x4 acc[2][2][4][2];
#pragma unroll
    for (int a = 0; a < 2; ++a)
#pragma unroll
        for (int b = 0; b < 2; ++b)
#pragma unroll
            for (int m = 0; m < 4; ++m)
#pragma unroll
                for (int n = 0; n < 2; ++n) acc[a][b][m][n] = (f32x4){0.f, 0.f, 0.f, 0.f};
    bf16x8 At[4][2], B0[2][2], B1[2][2];
    const char* cA = (const char*)g.A + (size_t)cur.pm * tstep + (size_t)cur.pn * g.a_pn_stride; const char* cB = (const char*)g.Bt + (size_t)cur.pn * tstep + ((TS && cur.half == 1) ? hstep : 0);
    bool fullc = !(TS && cur.half >= 0);
    PG8_STAGE(PG8_SB(0, 0), cB, voffB); PG8_STAGE(PG8_SB(0, 1), cB + hstep, voffB); PG8_STAGE(PG8_SA(0, 0), cA, voffA); PG8_STAGE(PG8_SA(0, 1), cA + hstepA, voffA);
    if (wr == 1) PG8_BAR;
    PG8_WAIT_V(2); PG8_BAR;
    PG8_STAGE(PG8_SB(1, 0), cB + kstep, voffB); PG8_STAGE(PG8_SA(1, 0), cA + kstep, voffA); PG8_STAGE(PG8_SB(1, 1), cB + hstep + kstep, voffB);
    PG8_WAIT_V(6); PG8_BAR;
    for (;;) {
        const bool has_next = S.next(ui + 1, nxt);
        const char* nA = has_next ? (const char*)g.A + (size_t)nxt.pm * tstep + (size_t)nxt.pn * g.a_pn_stride : cA; const char* nB = has_next ? (const char*)g.Bt + (size_t)nxt.pn * tstep + ((TS && nxt.half == 1) ? hstep : 0) : cB;
        for (int t = 0; t < nt; t += 2) {
            const bool last = (t == nt - 2);
            const char* a1 = cA + (size_t)(t + 1) * kstep;
            const char* a2 = last ? nA : cA + (size_t)(t + 2) * kstep; const char* b2 = last ? nB : cB + (size_t)(t + 2) * kstep;
            const char* a3 = a2 + kstep; const char* b3 = b2 + kstep;
            PG8_LDB(B0, 0, 0); if (!TS || fullc) PG8_LDB(B1, 0, 1); PG8_SCHED; PG8_LDA(At, 0, 0); PG8_STAGE(PG8_SA(1, 1), a1 + hstepA, voffA);
            PG8_WAIT_V(8); PG8_WAIT_L(0); PG8_BAR; PG8_MMA(0, 0, At, B0); if (!TS || fullc) PG8_MMA(0, 1, At, B1); PG8_BAR; PG8_SCHED;
            PG8_LDA(At, 0, 1); PG8_STAGE(PG8_SB(0, 0), b2, voffB); PG8_STAGE(PG8_SB(0, 1), b2 + hstep, voffB); PG8_STAGE(PG8_SA(0, 0), a2, voffA);
            PG8_WAIT_V(8); PG8_WAIT_L(0); PG8_BAR; PG8_MMA(1, 0, At, B0); if (!TS || fullc) PG8_MMA(1, 1, At, B1); PG8_BAR; PG8_SCHED;
            PG8_LDB(B0, 1, 0); if (!TS || fullc) PG8_LDB(B1, 1, 1); PG8_SCHED; PG8_LDA(At, 1, 0); PG8_STAGE(PG8_SA(0, 1), a2 + hstepA, voffA);
            PG8_WAIT_V(8); PG8_WAIT_L(0); PG8_BAR; PG8_MMA(0, 0, At, B0); if (!TS || fullc) PG8_MMA(0, 1, At, B1); PG8_BAR; PG8_SCHED;
            PG8_LDA(At, 1, 1); PG8_STAGE(PG8_SB(1, 0), b3, voffB); PG8_STAGE(PG8_SB(1, 1), b3 + hstep, voffB); PG8_STAGE(PG8_SA(1, 0), a3, voffA);
            PG8_WAIT_V(8); PG8_WAIT_L(0); PG8_BAR; PG8_MMA(1, 0, At, B0); if (!TS || fullc) PG8_MMA(1, 1, At, B1); PG8_BAR; PG8_SCHED;
        }
        if (wr == 0) PG8_BAR;
        E(acc, cur, wr, wc, fr, fq);
        if (!has_next) break;
#pragma unroll
        for (int a = 0; a < 2; ++a)
#pragma unroll
            for (int b = 0; b < 2; ++b)
#pragma unroll
                for (int m = 0; m < 4; ++m)
#pragma unroll
                    for (int n = 0; n < 2; ++n) acc[a][b][m][n] = (f32x4){0.f, 0.f, 0.f, 0.f};
        cur = nxt; cA = nA; cB = nB; ++ui; fullc = !(TS && cur.half >= 0);
        if (wr == 1) PG8_BAR;
    }
    PG8_WAIT_V(0);
    PG8_BAR;
#undef PG8_SA
#undef PG8_SB
#undef PG8_STAGE
#undef PG8_LDA
#undef PG8_LDB
#undef PG8_MMA
#undef PG8_WAIT_V
#undef PG8_WAIT_L
#undef PG8_BAR
#undef PG8_SCHED
}

typedef f32x4 Acc[2][2][4][2];

template <int CTRL> __device__ __forceinline__ float dppz(float v) { return __builtin_bit_cast(float, __builtin_amdgcn_update_dpp(0, __builtin_bit_cast(int, v), CTRL, 0xf, 0xf, true)); }
__device__ __forceinline__ float scan_up(float v) { v += dppz<0x111>(v); v += dppz<0x112>(v); v += dppz<0x114>(v); v += dppz<0x118>(v); return v; }
__device__ __forceinline__ float scan_dn(float v) { v += dppz<0x101>(v); v += dppz<0x102>(v); v += dppz<0x104>(v); v += dppz<0x108>(v); return v; }

struct EpiEven {
    bf16_t* OUT; bf16_t* CUS; bf16_t* GZS; bf16_t* U0; bf16_t* Z0; bf16_t* UT; const float* conv_w;
    template <int W> __device__ __forceinline__ void pooled(const Acc& acc, const Unit& u, int wr, int wc, int fr, int fq) const {
        const int chl = 128 * u.pn + 32 * wc + 8 * fq;
        const int blk = u.pm * 2 + wr;
        const size_t rowb = (size_t)u.pm * BM + wr * 128 + fr;
        float qprev[8];
#pragma unroll
        for (int e = 0; e < 8; ++e) qprev[e] = 0.f;
#pragma unroll
        for (int g8 = 0; g8 < 8; ++g8) { const int ai = g8 >> 2, m = g8 & 3;
            float uu[8], zz[8], o[8];
#pragma unroll
            for (int n = 0; n < 2; ++n)
#pragma unroll
                for (int j = 0; j < 4; ++j) { uu[4 * n + j] = acc[ai][0][m][n][j]; zz[4 * n + j] = silu_f(acc[ai][1][m][n][j]); }
#pragma unroll
            for (int e = 0; e < 8; ++e) {
                float cur = uu[e], q = uu[e];
                if constexpr (W >= 2)  { cur += dppz<0x111>(cur); q += dppz<0x101>(q); }
                if constexpr (W >= 4)  { cur += dppz<0x112>(cur); q += dppz<0x102>(q); }
                if constexpr (W >= 8)  { cur += dppz<0x114>(cur); q += dppz<0x104>(q); }
                if constexpr (W >= 16) { cur += dppz<0x118>(cur); q += dppz<0x108>(q); }
                const float prv = dppz<0x100 + ((17 - W) & 15)>(qprev[e]);
                o[e] = ((cur + prv) * (1.0f / W) - uu[e]) * zz[e]; qprev[e] = q; }
            const size_t row = rowb + ai * 64 + m * 16;
            if (!(g8 == 0 && fr < 15)) *(u32x4*)(OUT + row * EVEN_W + chl) = pack8v(o);
            if (g8 == 0 && fr < 15) { *(u32x4*)(U0 + ((size_t)blk * 15 + fr) * 1024 + chl) = pack8v(uu); *(u32x4*)(Z0 + ((size_t)blk * 15 + fr) * 1024 + chl) = pack8v(zz); }
            if (g8 == 7 && fr >= 1) *(u32x4*)(UT + ((size_t)blk * 15 + fr - 1) * 1024 + chl) = pack8v(uu);
        }
    }
    __device__ __forceinline__ void operator()(const Acc& acc, const Unit& u, int wr, int wc, int fr, int fq) const {
        const int pn = u.pn;
        if (pn < 8) {
            switch (pn >> 1) { case 0: pooled<2>(acc, u, wr, wc, fr, fq); break; case 1: pooled<4>(acc, u, wr, wc, fr, fq); break;
                               case 2: pooled<8>(acc, u, wr, wc, fr, fq); break; default: pooled<16>(acc, u, wr, wc, fr, fq); break; }
        } else {
            const int row0 = u.pm * BM + wr * 128 + fr;
            const int ch0 = 64 * (pn - 8) + 16 * wc + 4 * fq;
            const f32x4 cw0 = *(const f32x4*)(conv_w + ch0), cw1 = *(const f32x4*)(conv_w + 1024 + ch0), cw2 = *(const f32x4*)(conv_w + 2048 + ch0);
#pragma unroll
            for (int ai = 0; ai < 2; ++ai) {
                const int grp = u.pm * 4 + wr * 2 + ai;
                f32x4 cup = (f32x4){0.f, 0.f, 0.f, 0.f};
#pragma unroll
                for (int m = 0; m < 4; ++m) {
                    const f32x4 cu = acc[ai][0][m][0] * acc[ai][0][m][1];
                    f32x4 gz = acc[ai][1][m][1];
#pragma unroll
                    for (int j = 0; j < 4; ++j) gz[j] = silu_f(gz[j]);
                    gz = gz * acc[ai][1][m][0];
                    f32x4 o;
#pragma unroll
                    for (int j = 0; j < 4; ++j) {
                        const float q1 = dppz<0x111>(cu[j]) + dppz<0x10F>(cup[j]);
                        const float q2 = dppz<0x112>(cu[j]) + dppz<0x10E>(cup[j]);
                        o[j] = gz[j] * (cw2[j] * cu[j] + cw1[j] * q1 + cw0[j] * q2); }
                    cup = cu;
                    const size_t row = (size_t)(row0 + ai * 64 + m * 16);
                    u32x2 w; w.x = cvt_pk_bf16(o[0], o[1]); w.y = cvt_pk_bf16(o[2], o[3]);
                    if (!(m == 0 && fr < 2)) *(u32x2*)(OUT + row * EVEN_W + 1024 + ch0) = w;
                    if (m == 0 && fr < 2) { u32x2 c2; c2.x = cvt_pk_bf16(cu[0], cu[1]); c2.y = cvt_pk_bf16(cu[2], cu[3]); u32x2 g2; g2.x = cvt_pk_bf16(gz[0], gz[1]); g2.y = cvt_pk_bf16(gz[2], gz[3]);
                        *(u32x2*)(CUS + (size_t)(grp * 4 + fr) * 1024 + ch0) = c2; *(u32x2*)(GZS + (size_t)(grp * 2 + fr) * 1024 + ch0) = g2; }
                    if (m == 3 && fr >= 14) { u32x2 c2; c2.x = cvt_pk_bf16(cu[0], cu[1]); c2.y = cvt_pk_bf16(cu[2], cu[3]);
                        *(u32x2*)(CUS + (size_t)(grp * 4 + 2 + (fr - 14)) * 1024 + ch0) = c2; }
                }
            }
        }
    }
};

struct EpiRes1 {
    bf16_t* h1b; const float* rs0  ; const float* g0; float* ss;
    __device__ __forceinline__ void operator()(const Acc& acc, const Unit& u, int wr, int wc, int fr, int fq) const {
        const int row0 = u.pm * BM + wr * 64 + fr, col0 = u.pn * BM + wc * 32 + 8 * fq;
        f32x4 ig[2][2]; float rs[2][4];
#pragma unroll
        for (int bj = 0; bj < 2; ++bj)
#pragma unroll
            for (int n = 0; n < 2; ++n) { const f32x4 g = *(const f32x4*)(g0 + col0 + bj * HALF + 4 * n); ig[bj][n] = (f32x4){1.0f / g[0], 1.0f / g[1], 1.0f / g[2], 1.0f / g[3]}; }
#pragma unroll
        for (int ai = 0; ai < 2; ++ai)
#pragma unroll
            for (int m = 0; m < 4; ++m) rs[ai][m] = rs0[row0 + ai * HALF + m * 16];
#pragma unroll
        for (int ai = 0; ai < 2; ++ai)
#pragma unroll
            for (int m = 0; m < 4; ++m) { const size_t row = (size_t)(row0 + ai * HALF + m * 16); float sq = 0.f; const float r_ = rs[ai][m];
#pragma unroll
                for (int bj = 0; bj < 2; ++bj) { const size_t off = row * D + col0 + bj * HALF;
                    const u32x4 h = *(const u32x4*)(h1b + off);
                    const f32x4 x0 = (f32x4){bf_lo(h.x), bf_hi(h.x), bf_lo(h.y), bf_hi(h.y)} * r_ * ig[bj][0], x1 = (f32x4){bf_lo(h.z), bf_hi(h.z), bf_lo(h.w), bf_hi(h.w)} * r_ * ig[bj][1];
                    const f32x4 v0 = acc[ai][bj][m][0] + x0, v1 = acc[ai][bj][m][1] + x1;
                    sq += (v0[0] * v0[0] + v0[1] * v0[1]) + (v0[2] * v0[2] + v0[3] * v0[3]) + (v1[0] * v1[0] + v1[1] * v1[1]) + (v1[2] * v1[2] + v1[3] * v1[3]);
                    u32x4 w; w.x = cvt_pk_bf16(v0[0], v0[1]); w.y = cvt_pk_bf16(v0[2], v0[3]); w.z = cvt_pk_bf16(v1[0], v1[1]); w.w = cvt_pk_bf16(v1[2], v1[3]);
                    *(u32x4*)(h1b + off) = w; }
                sq += __shfl_xor(sq, 16); sq += __shfl_xor(sq, 32);
                if (fq == 0) ss[row * 16 + u.pn * 4 + wc] = sq; }
    }
};
struct EpiFinal {
    const bf16_t* h1b; float* out; const float* bias; const float* gF; float* slots; unsigned* cnt; LAS unsigned char* xl;
    __device__ __forceinline__ void operator()(Acc& acc, const Unit& u, int wr, int wc, int fr, int fq) const {
        LAS float* P = (LAS float*)xl;
        LAS float* S = (LAS float*)(xl + 4096);
        int tid = threadIdx.x; asm volatile("" : "+v"(tid));
        const int lane = tid & 63, wid = __builtin_amdgcn_readfirstlane(tid >> 6);
        const int row0 = u.pm * BM + wr * 64 + fr, col0 = u.pn * BM + wc * 32 + 8 * fq;
        f32x4 bv[2][2];
#pragma unroll
        for (int bj = 0; bj < 2; ++bj)
#pragma unroll
            for (int n = 0; n < 2; ++n) bv[bj][n] = *(const f32x4*)(bias + col0 + bj * HALF + 4 * n);
#pragma unroll
        for (int ai = 0; ai < 2; ++ai)
#pragma unroll
            for (int m = 0; m < 4; ++m) { const size_t row = (size_t)(row0 + ai * HALF + m * 16); float sq = 0.f;
#pragma unroll
                for (int bj = 0; bj < 2; ++bj) { const u32x4 h = *(const u32x4*)(h1b + row * D + col0 + bj * HALF);
                    const f32x4 r0 = (f32x4){bf_lo(h.x), bf_hi(h.x), bf_lo(h.y), bf_hi(h.y)}, r1 = (f32x4){bf_lo(h.z), bf_hi(h.z), bf_lo(h.w), bf_hi(h.w)};
                    const f32x4 v0 = acc[ai][bj][m][0] + bv[bj][0] + r0, v1 = acc[ai][bj][m][1] + bv[bj][1] + r1;
                    acc[ai][bj][m][0] = v0; acc[ai][bj][m][1] = v1;
                    sq += (v0[0] * v0[0] + v0[1] * v0[1]) + (v0[2] * v0[2] + v0[3] * v0[3]) + (v1[0] * v1[0] + v1[1] * v1[1]) + (v1[2] * v1[2] + v1[3] * v1[3]); }
                sq += __shfl_xor(sq, 16); sq += __shfl_xor(sq, 32);
                if (fq == 0) P[(ai * HALF + wr * 64 + m * 16 + fr) * 4 + wc] = sq; }
        asm volatile("s_waitcnt lgkmcnt(0)" ::: "memory"); __builtin_amdgcn_s_barrier(); asm volatile("" ::: "memory");
        if (tid < 256) { const float t_ = (P[tid * 4 + 0] + P[tid * 4 + 1]) + (P[tid * 4 + 2] + P[tid * 4 + 3]);
            __hip_atomic_store(slots + ((size_t)(u.pm * BM + tid) * 4 + u.pn), t_, __ATOMIC_RELAXED, __HIP_MEMORY_SCOPE_AGENT); }
        asm volatile("s_waitcnt vmcnt(0)" ::: "memory");
        if (lane == 0 && wid < 4) __hip_atomic_fetch_add(cnt + 16 * u.pm, 1u, __ATOMIC_RELAXED, __HIP_MEMORY_SCOPE_AGENT);
        if (wid == 0) { unsigned sp = 0;
            while ((unsigned)__builtin_amdgcn_readfirstlane((int)__hip_atomic_load(cnt + 16 * u.pm, __ATOMIC_RELAXED, __HIP_MEMORY_SCOPE_AGENT)) < 16u) { __builtin_amdgcn_s_sleep(1); if (++sp > (1u << 22)) break; }
            __builtin_amdgcn_fence(__ATOMIC_ACQUIRE, "agent"); }
        asm volatile("s_waitcnt vmcnt(0) lgkmcnt(0)" ::: "memory"); __builtin_amdgcn_s_barrier(); asm volatile("" ::: "memory");
        if (tid < 256) { const float* sl = slots + (size_t)(u.pm * BM + tid) * 4; float t_ = 0.f;
#pragma unroll
            for (int k = 0; k < 4; ++k) t_ += __hip_atomic_load(sl + k, __ATOMIC_RELAXED, __HIP_MEMORY_SCOPE_AGENT);
            S[tid] = rsqrtf(t_ * (1.0f / D) + EPS); }
        asm volatile("s_waitcnt lgkmcnt(0)" ::: "memory"); __builtin_amdgcn_s_barrier(); asm volatile("" ::: "memory");
        f32x4 gv[2][2];
#pragma unroll
        for (int bj = 0; bj < 2; ++bj)
#pragma unroll
            for (int n = 0; n < 2; ++n) gv[bj][n] = *(const f32x4*)(gF + col0 + bj * HALF + 4 * n);
#pragma unroll
        for (int ai = 0; ai < 2; ++ai)
#pragma unroll
            for (int m = 0; m < 4; ++m) { const size_t row = (size_t)(row0 + ai * HALF + m * 16); const float rs = S[ai * HALF + wr * 64 + m * 16 + fr];
#pragma unroll
                for (int bj = 0; bj < 2; ++bj) { float* op = out + row * D + col0 + bj * HALF;
                    *(f32x4*)op = acc[ai][bj][m][0] * rs * gv[bj][0]; *(f32x4*)(op + 4) = acc[ai][bj][m][1] * rs * gv[bj][1]; } }
    }
};

struct EpiQKVZ {
    bf16_t* O; const float* bias; const float* cosT; const float* sinT; const LAS float* rstd_lds;
    __device__ __forceinline__ void operator()(const Acc& acc, const Unit& u, int wr, int wc, int fr, int fq) const {
        const int row0 = u.pm * BM + wr * 64 + fr, col0 = u.pn * BM + wc * 32 + 8 * fq;
        const int pn = u.pn;
        const bool halfu = u.half >= 0;
        f32x4 bv[2][2];
#pragma unroll
        for (int bj = 0; bj < 2; ++bj)
#pragma unroll
            for (int n = 0; n < 2; ++n) bv[bj][n] = *(const f32x4*)(bias + col0 + (halfu ? u.half : bj) * HALF + 4 * n);
        const bool rot_wave = ((wc & 1) == 0) && (pn <= 4);
        const LAS float* rl = rstd_lds + u.idx * 256 + wr * 64 + fr;
#pragma unroll
        for (int ai = 0; ai < 2; ++ai)
#pragma unroll
            for (int m = 0; m < 4; ++m) { const size_t row = (size_t)(row0 + ai * HALF + m * 16);
                const float rstd = rl[ai * HALF + m * 16];
                f32x4 cs[2], sn[2];
                if (rot_wave) { cs[0] = *(const f32x4*)(cosT + row * 8); cs[1] = *(const f32x4*)(cosT + row * 8 + 4); sn[0] = *(const f32x4*)(sinT + row * 8); sn[1] = *(const f32x4*)(sinT + row * 8 + 4); }
                else { cs[0] = cs[1] = sn[0] = sn[1] = (f32x4){0.f, 0.f, 0.f, 0.f}; }
#pragma unroll
                for (int bj = 0; bj < 2; ++bj) {
                    if (halfu && bj == 1) continue;
                    const int cb = halfu ? u.half : bj;
                    f32x4 v[2];
                    v[0] = acc[ai][bj][m][0] * rstd + bv[bj][0]; v[1] = acc[ai][bj][m][1] * rstd + bv[bj][1];
                    const bool is_q = pn < 4, is_k = (pn == 4 && cb == 0), is_z = pn > 4;
                    if (rot_wave && (is_q || is_k)) {
#pragma unroll
                        for (int n = 0; n < 2; ++n)
#pragma unroll
                            for (int j = 0; j < 4; ++j) { const float x = v[n][j]; const float p = __shfl_xor(x, 16);
                                const float r0 = x * cs[n][j] - p * sn[n][j], r1 = x * cs[n][j] + p * sn[n][j];
                                v[n][j] = (fq == 0) ? r0 : ((fq == 1) ? r1 : x); }
                    }
                    if (is_q) { v[0] = v[0] * C2; v[1] = v[1] * C2; }
                    if (is_z) {
#pragma unroll
                        for (int n = 0; n < 2; ++n)
#pragma unroll
                            for (int j = 0; j < 4; ++j) v[n][j] = silu_f(v[n][j]); }
                    u32x4 w; w.x = cvt_pk_bf16(v[0][0], v[0][1]); w.y = cvt_pk_bf16(v[0][2], v[0][3]); w.z = cvt_pk_bf16(v[1][0], v[1][1]); w.w = cvt_pk_bf16(v[1][2], v[1][3]);
                    __builtin_nontemporal_store(w, (u32x4*)(O + row * ODD_IN + col0 + cb * HALF)); } }
    }
};
}

__device__ __forceinline__ float wave_sum(float v) {
#pragma unroll
    for (int o = 1; o < 64; o <<= 1) v += __shfl_xor(v, o);
    return v;
}
__device__ __forceinline__ int even_dst_row(int s);
__device__ __forceinline__ void p0_transpose_item(const float* W, int K, int N, bf16_t* WT, int row_off, LAS float* scr, int k0, int n0, int lane, const float* kscale = nullptr, bool evenmap = false) {
#pragma unroll
    for (int i = 0; i < 32; ++i) { const int kk = 2 * i + (lane >> 5); float wv = __builtin_nontemporal_load(W + (size_t)(k0 + kk) * N + n0 + (lane & 31)); if (kscale) wv *= kscale[k0 + kk]; scr[kk * 33 + (lane & 31)] = wv; }
    asm volatile("s_waitcnt lgkmcnt(0)" ::: "memory");
    const int c = lane & 7;
#pragma unroll
    for (int j = 0; j < 4; ++j) { const int n = (lane >> 3) + 8 * j; const LAS float* s = scr + (8 * c) * 33 + n;
        u32x4 o; o.x = cvt_pk_bf16(s[0 * 33], s[1 * 33]); o.y = cvt_pk_bf16(s[2 * 33], s[3 * 33]); o.z = cvt_pk_bf16(s[4 * 33], s[5 * 33]); o.w = cvt_pk_bf16(s[6 * 33], s[7 * 33]);
        const int drow = evenmap ? even_dst_row(n0 + n) : row_off + n0 + n;
        *(u32x4*)(WT + (size_t)drow * K + k0 + 8 * c) = o; }
    asm volatile("s_waitcnt lgkmcnt(0)" ::: "memory");
}

__device__ __forceinline__ void p0_fold_item(const float* Win, const float* Wp, const float* ps, bf16_t* WT1, int item, int lane) {
    const int dt = item & 7, kt = (item >> 3) & 31, g = item >> 8;
    const int r32 = lane & 31, hi = lane >> 5, k0 = kt * 32, d0 = dt * 32;
    const float* ap = Win + (size_t)(k0 + r32) * EVEN_IN + g * 256 + 16 * hi;
    const float* bp = Wp + (size_t)g * 65536 + (size_t)(16 * hi) * 256 + d0 + r32;
    f32x16 acc;
#pragma unroll
    for (int r = 0; r < 16; ++r) acc[r] = 0.f;
    f32x4 a4[2][4]; float b[2][16];
#pragma unroll
    for (int q = 0; q < 4; ++q) a4[0][q] = *(const f32x4*)(ap + 4 * q);
#pragma unroll
    for (int j = 0; j < 16; ++j) b[0][j] = bp[(size_t)j * 256];
#pragma unroll
    for (int ci = 0; ci < 8; ++ci) { const int cb = ci & 1, nb = cb ^ 1, base = 32 * (ci + 1);
        if (ci < 7) {
#pragma unroll
            for (int q = 0; q < 4; ++q) a4[nb][q] = *(const f32x4*)(ap + base + 4 * q);
#pragma unroll
            for (int j = 0; j < 16; ++j) b[nb][j] = bp[(size_t)(base + j) * 256]; }
#pragma unroll
        for (int j = 0; j < 16; ++j) acc = __builtin_amdgcn_mfma_f32_32x32x2f32(a4[cb][j >> 2][j & 3], b[cb][j], acc, 0, 0, 0);
    }
    const float sc = ps[g * 256 + d0 + r32];
    const int uc = g * 256 + d0 + r32;
    bf16_t* op = WT1 + (size_t)((uc >> 7) * 256 + (uc & 127)) * D + k0 + 4 * hi;
#pragma unroll
    for (int q = 0; q < 4; ++q) { u32x2 o; o.x = cvt_pk_bf16(acc[4 * q + 0] * sc, acc[4 * q + 1] * sc); o.y = cvt_pk_bf16(acc[4 * q + 2] * sc, acc[4 * q + 3] * sc); *(u32x2*)(op + 8 * q) = o; }
}
__device__ __forceinline__ int even_dst_row(int s) {
    const int seg = s >> 10, ch = s & 1023;
    if (seg == 4) return (ch >> 7) * 256 + 128 + (ch & 127);
    const int q = (seg == 2) ? 0 : (seg == 3) ? 1 : (seg == 1) ? 2 : 3;
    return (8 + (ch >> 6)) * 256 + 128 * (q >> 1) + 32 * ((ch >> 4) & 3) + 8 * ((ch >> 2) & 3) + 4 * (q & 1) + (ch & 3);
}
__device__ const float INVF[8] = {1.0f, 0.19392274474868576f, 0.03760603093086393f, 0.007292664737217109f, 0.001414213562373095f, 0.0002742481756762073f, 5.318295896944988e-05f, 1.031338537721246e-05f};

struct Args { const void* in[14]; float* out; unsigned char* ws; int ph_lo, ph_hi, rep_mask, pad; };

__device__ __forceinline__ void unpack8(const u32x4 w, float (&f)[8]) {
    f[0] = bf_lo(w.x); f[1] = bf_hi(w.x); f[2] = bf_lo(w.y); f[3] = bf_hi(w.y); f[4] = bf_lo(w.z); f[5] = bf_hi(w.z); f[6] = bf_lo(w.w); f[7] = bf_hi(w.w);
}
__device__ __forceinline__ u32x4 pack8(const float (&f)[8]) {
    u32x4 w; w.x = cvt_pk_bf16(f[0], f[1]); w.y = cvt_pk_bf16(f[2], f[3]); w.z = cvt_pk_bf16(f[4], f[5]); w.w = cvt_pk_bf16(f[6], f[7]); return w;
}
constexpr int RUN = 32, NRUN = M / RUN, NCH = 128;
template <int W> __device__ __forceinline__ void p2_pool_item(bf16_t* OUT, const bf16_t* U0, const bf16_t* Z0, const bf16_t* UT, int blk, int c0) {
    const bool first = ((blk * 128) % SEQ) == 0;
    const bf16_t* u0 = U0 + (size_t)blk * 15 * 1024 + c0; const bf16_t* z0 = Z0 + (size_t)blk * 15 * 1024 + c0;
    const bf16_t* ut = UT + ((size_t)blk * 15 - 15) * 1024 + c0;
    u32x4 lu[15], lz[5], lt[W - 1];
#pragma unroll
    for (int t = 0; t < 15; ++t) lu[t] = __builtin_nontemporal_load((const u32x4*)(u0 + (size_t)t * 1024));
#pragma unroll
    for (int k = 1; k < W; ++k) lt[k - 1] = first ? (u32x4){0u, 0u, 0u, 0u} : __builtin_nontemporal_load((const u32x4*)(ut + (size_t)(15 - k) * 1024));
    float sum[8];
#pragma unroll
    for (int e = 0; e < 8; ++e) sum[e] = 0.f;
#pragma unroll
    for (int k = 1; k < W; ++k) { float f[8]; unpack8(lt[k - 1], f);
#pragma unroll
        for (int e = 0; e < 8; ++e) sum[e] += f[e]; }
#pragma unroll
    for (int t = 0; t < 15; ++t) {
        if (t % 5 == 0) {
#pragma unroll
            for (int q = 0; q < 5; ++q) lz[q] = __builtin_nontemporal_load((const u32x4*)(z0 + (size_t)(t + q) * 1024)); }
        float cur[8], sz[8], o[8]; unpack8(lu[t], cur); unpack8(lz[t % 5], sz);
        const int cnt = first ? ((t + 1 < W) ? (t + 1) : W) : W; const float inv = 1.0f / (float)cnt;
#pragma unroll
        for (int e = 0; e < 8; ++e) { sum[e] += cur[e]; o[e] = (sum[e] * inv - cur[e]) * sz[e]; }
        *(u32x4*)(OUT + (size_t)(blk * 128 + t) * EVEN_W + c0) = pack8(o);
        const int idx = t - W + 1;
        float old[8];
        if (idx >= 0) unpack8(lu[idx >= 0 ? idx : 0], old); else unpack8(lt[(-idx - 1) < (W - 1) ? (-idx - 1) : 0], old);
#pragma unroll
        for (int e = 0; e < 8; ++e) sum[e] -= old[e];
    }
}
__device__ __forceinline__ void p2_phase(bf16_t* OUT, const bf16_t* CUS, const bf16_t* GZS, const bf16_t* U0, const bf16_t* Z0, const bf16_t* UT, const float* conv_w, int gtid, int gthreads) {
    for (int it = gtid; it < (M / 128) * NCH; it += gthreads) {
        const int blk = it / NCH, chunk = it % NCH, c0 = chunk * 8;
        switch (chunk >> 5) { case 0: p2_pool_item<2>(OUT, U0, Z0, UT, blk, c0); break; case 1: p2_pool_item<4>(OUT, U0, Z0, UT, blk, c0); break;
                              case 2: p2_pool_item<8>(OUT, U0, Z0, UT, blk, c0); break; default: p2_pool_item<16>(OUT, U0, Z0, UT, blk, c0); break; }
    }
    for (int it = gtid; it < (M / 64) * NCH; it += gthreads) {
        const int grp = it / NCH, c0 = (it % NCH) * 8; const bool first = ((grp * 64) % SEQ) == 0;
        float cw0[8], cw1[8], cw2[8], cu0[8], cu1[8], pm1[8], pm2[8], gz0[8], gz1[8], o0[8], o1[8];
#pragma unroll
        for (int e = 0; e < 8; ++e) { cw0[e] = conv_w[c0 + e]; cw1[e] = conv_w[1024 + c0 + e]; cw2[e] = conv_w[2048 + c0 + e]; pm1[e] = 0.f; pm2[e] = 0.f; }
        unpack8(__builtin_nontemporal_load((const u32x4*)(CUS + (size_t)(grp * 4 + 0) * 1024 + c0)), cu0); unpack8(__builtin_nontemporal_load((const u32x4*)(CUS + (size_t)(grp * 4 + 1) * 1024 + c0)), cu1);
        unpack8(__builtin_nontemporal_load((const u32x4*)(GZS + (size_t)(grp * 2 + 0) * 1024 + c0)), gz0); unpack8(__builtin_nontemporal_load((const u32x4*)(GZS + (size_t)(grp * 2 + 1) * 1024 + c0)), gz1);
        if (!first) { unpack8(__builtin_nontemporal_load((const u32x4*)(CUS + (size_t)((grp - 1) * 4 + 3) * 1024 + c0)), pm1); unpack8(__builtin_nontemporal_load((const u32x4*)(CUS + (size_t)((grp - 1) * 4 + 2) * 1024 + c0)), pm2); }
#pragma unroll
        for (int e = 0; e < 8; ++e) { o0[e] = gz0[e] * (cw2[e] * cu0[e] + cw1[e] * pm1[e] + cw0[e] * pm2[e]); o1[e] = gz1[e] * (cw2[e] * cu1[e] + cw1[e] * cu0[e] + cw0[e] * pm1[e]); }
        *(u32x4*)(OUT + (size_t)(grp * 64) * EVEN_W + 1024 + c0) = pack8(o0); *(u32x4*)(OUT + (size_t)(grp * 64 + 1) * EVEN_W + 1024 + c0) = pack8(o1);
    }
}

__device__ __forceinline__ int crow(int r, int hi) { return (r & 3) + 8 * (r >> 2) + 4 * hi; }
constexpr int KS_STRIDE = 72, VT_STRIDE = 260, VT_OFF = 256 * KS_STRIDE * 2, ATT_WB_OFF = 70656;
static_assert(VT_OFF + 64 * VT_STRIDE * 2 <= ATT_WB_OFF && ATT_WB_OFF + 8 * 32 * KS_STRIDE * 2 <= 131072, "attention LDS map");
__device__ __forceinline__ void attn_phase(LAS unsigned char* lds, const bf16_t* P1, bf16_t* ATT, const float* sinks, int vcu, int G) {
    int tid = threadIdx.x; asm volatile("" : "+v"(tid));
    const int lane = tid & 63, wid = __builtin_amdgcn_readfirstlane(tid >> 6), r32 = lane & 31, hi = lane >> 5;
    LAS bf16_t* Ks = (LAS bf16_t*)lds;
    LAS bf16_t* Vt = (LAS bf16_t*)(lds + VT_OFF);
    LAS bf16_t* wb = (LAS bf16_t*)(lds + ATT_WB_OFF) + wid * (32 * KS_STRIDE);
    const int crow_ = lane >> 3, cpc = (lane & 7) * 8;
    constexpr int NU = (M / 128) * 2;
    u32x4 kvr[4], vvr[4];
#define ATT_LOAD_KV(unit_) do { const int kh_ = (unit_) & 1, blk_ = (unit_) >> 1, n_ = blk_ & 63; const unsigned R0_ = (unsigned)blk_ * 128u; \
        _Pragma("unroll") for (int i = 0; i < 4; ++i) { const int p = tid + 512 * i, key = p >> 3, ch = p & 7; \
            kvr[i] = (u32x4){0u, 0u, 0u, 0u}; vvr[i] = (u32x4){0u, 0u, 0u, 0u}; \
            if ((n_ > 0) || (key >= 128)) { const bf16_t* rp = P1 + ((R0_ + (unsigned)key - 128u) * (unsigned)ODD_IN + (unsigned)(kh_ * 64 + ch * 8)); kvr[i] = __builtin_nontemporal_load((const u32x4*)(rp + 1024)); vvr[i] = __builtin_nontemporal_load((const u32x4*)(rp + 1152)); } } } while (0)
    int unit = vcu;
    if (unit < NU) ATT_LOAD_KV(unit);
    for (; unit < NU; unit += G) {
        const int kh = unit & 1, blk = unit >> 1, n = blk & 63;
        const unsigned R0 = (unsigned)blk * 128u;
        __syncthreads();
#pragma unroll
        for (int i = 0; i < 4; ++i) {
            const int p = tid + 512 * i, key = p >> 3, ch = p & 7;
            const u32x4 kv = kvr[i], vv = vvr[i];
            *(LAS u32x4*)(Ks + key * KS_STRIDE + ch * 8) = kv;
            LAS bf16_t* vp = Vt + (ch * 8) * VT_STRIDE + key;
            vp[0 * VT_STRIDE] = (bf16_t)(vv.x & 0xffffu); vp[1 * VT_STRIDE] = (bf16_t)(vv.x >> 16);
            vp[2 * VT_STRIDE] = (bf16_t)(vv.y & 0xffffu); vp[3 * VT_STRIDE] = (bf16_t)(vv.y >> 16);
            vp[4 * VT_STRIDE] = (bf16_t)(vv.z & 0xffffu); vp[5 * VT_STRIDE] = (bf16_t)(vv.z >> 16);
            vp[6 * VT_STRIDE] = (bf16_t)(vv.w & 0xffffu); vp[7 * VT_STRIDE] = (bf16_t)(vv.w >> 16);
        }
        __syncthreads();
        if (unit + G < NU) ATT_LOAD_KV(unit + G);
        const int h = kh * 8 + wid;
        const float sink2 = sinks[h] * LOG2E;
        u32x4 qn[4], gn[4];
#define ATT_LOAD_QG(c_) do { const unsigned tk_ = R0 + 32u * (unsigned)(c_) + (unsigned)crow_; const bf16_t* qp_ = P1 + (tk_ * (unsigned)ODD_IN + (unsigned)(h * 64 + cpc)); \
        _Pragma("unroll") for (int i = 0; i < 4; ++i) { qn[i] = __builtin_nontemporal_load((const u32x4*)(qp_ + (unsigned)(8 * i) * (unsigned)ODD_IN)); gn[i] = __builtin_nontemporal_load((const u32x4*)(qp_ + (unsigned)(8 * i) * (unsigned)ODD_IN + 1280)); } } while (0)
        ATT_LOAD_QG(0);
        for (int c = 0; c < 4; ++c) {
            bf16x8 qf[4]; u32x2 gz[2][4];
#pragma unroll
            for (int i = 0; i < 4; ++i) *(LAS u32x4*)(wb + (crow_ + 8 * i) * KS_STRIDE + cpc) = qn[i];
#pragma unroll
            for (int d0 = 0; d0 < 4; ++d0) qf[d0] = *(const LAS bf16x8*)(wb + r32 * KS_STRIDE + d0 * 16 + hi * 8);
            asm volatile("s_waitcnt lgkmcnt(0)" ::: "memory");
#pragma unroll
            for (int i = 0; i < 4; ++i) *(LAS u32x4*)(wb + (crow_ + 8 * i) * KS_STRIDE + cpc) = gn[i];
#pragma unroll
            for (int dt = 0; dt < 2; ++dt)
#pragma unroll
                for (int g4 = 0; g4 < 4; ++g4) gz[dt][g4] = *(const LAS u32x2*)(wb + r32 * KS_STRIDE + 32 * dt + 8 * g4 + 4 * hi);
            asm volatile("s_waitcnt lgkmcnt(0)" ::: "memory");
            if (c < 3) ATT_LOAD_QG(c + 1);
            f32x16 st[5];
#pragma unroll
            for (int kt = 0; kt < 5; ++kt) {
                f32x16 a; const float a0 = ((n == 0) && (c + kt < 4)) ? -INFINITY : 0.f;
#pragma unroll
                for (int r = 0; r < 16; ++r) a[r] = a0;
#pragma unroll
                for (int d0 = 0; d0 < 4; ++d0) { const bf16x8 kf = *(const LAS bf16x8*)(Ks + (32 * (c + kt) + r32) * KS_STRIDE + d0 * 16 + hi * 8);
                    a = __builtin_amdgcn_mfma_f32_32x32x16_bf16(kf, qf[d0], a, 0, 0, 0); }
                st[kt] = a;
            }
            float mx = sink2;
#pragma unroll
            for (int kt = 0; kt < 5; ++kt)
#pragma unroll
                for (int r = 0; r < 16; ++r) { const int dd = 32 * kt + crow(r, hi) - r32;
                    float s_ = st[kt][r];
                    if (kt == 0) s_ = (dd >= 1) ? s_ : -INFINITY;
                    if (kt == 4) s_ = (dd <= 128) ? s_ : -INFINITY;
                    st[kt][r] = s_; }
            { float ma = mx, mb = mx;
#pragma unroll
              for (int kt = 0; kt < 5; ++kt)
#pragma unroll
                  for (int r = 0; r < 16; r += 4) { ma = __builtin_fmaxf(__builtin_fmaxf(ma, st[kt][r]), st[kt][r + 1]); mb = __builtin_fmaxf(__builtin_fmaxf(mb, st[kt][r + 2]), st[kt][r + 3]); }
              mx = __builtin_fmaxf(ma, mb); }
            { auto rr = __builtin_amdgcn_permlane32_swap(__float_as_uint(mx), __float_as_uint(mx), false, false); mx = fmaxf(__uint_as_float(rr[0]), __uint_as_float(rr[1])); }
            float l = 0.f;
#pragma unroll
            for (int kt = 0; kt < 5; ++kt)
#pragma unroll
                for (int r = 0; r < 16; ++r) { const float p = __builtin_amdgcn_exp2f(st[kt][r] - mx); st[kt][r] = p; l += p; }
            { auto rr = __builtin_amdgcn_permlane32_swap(__float_as_uint(l), __float_as_uint(l), false, false); l = __uint_as_float(rr[0]) + __uint_as_float(rr[1]); }
            l += __builtin_amdgcn_exp2f(sink2 - mx);
            f32x16 o[2];
#pragma unroll
            for (int r = 0; r < 16; ++r) { o[0][r] = 0.f; o[1][r] = 0.f; }
#pragma unroll
            for (int kt = 0; kt < 5; ++kt)
#pragma unroll
                for (int s_ = 0; s_ < 2; ++s_) {
                    u32x4 pw; pw.x = cvt_pk_bf16(st[kt][8 * s_ + 0], st[kt][8 * s_ + 1]); pw.y = cvt_pk_bf16(st[kt][8 * s_ + 2], st[kt][8 * s_ + 3]);
                    pw.z = cvt_pk_bf16(st[kt][8 * s_ + 4], st[kt][8 * s_ + 5]); pw.w = cvt_pk_bf16(st[kt][8 * s_ + 6], st[kt][8 * s_ + 7]);
                    const bf16x8 pf = __builtin_bit_cast(bf16x8, pw);
#pragma unroll
                    for (int dt = 0; dt < 2; ++dt) {
                        const LAS bf16_t* vp = Vt + (32 * dt + r32) * VT_STRIDE + 32 * (c + kt) + 16 * s_ + 4 * hi;
                        const s16x4 lo = *(const LAS s16x4*)vp, hi4 = *(const LAS s16x4*)(vp + 8);
                        const bf16x8 vf = (bf16x8){lo[0], lo[1], lo[2], lo[3], hi4[0], hi4[1], hi4[2], hi4[3]};
                        o[dt] = __builtin_amdgcn_mfma_f32_32x32x16_bf16(vf, pf, o[dt], 0, 0, 0);
                    }
                }
            const float rl = 1.0f / l;
#pragma unroll
            for (int dt = 0; dt < 2; ++dt)
#pragma unroll
                for (int g4 = 0; g4 < 4; ++g4) {
                    const u32x2 gzz = gz[dt][g4];
                    u32x2 w; w.x = cvt_pk_bf16(o[dt][4 * g4 + 0] * rl * bf_lo(gzz.x), o[dt][4 * g4 + 1] * rl * bf_hi(gzz.x));
                    w.y = cvt_pk_bf16(o[dt][4 * g4 + 2] * rl * bf_lo(gzz.y), o[dt][4 * g4 + 3] * rl * bf_hi(gzz.y));
                    *(LAS u32x2*)(wb + r32 * KS_STRIDE + 32 * dt + 8 * g4 + 4 * hi) = w;
                }
            asm volatile("s_waitcnt lgkmcnt(0)" ::: "memory");
            { bf16_t* op = ATT + ((R0 + 32u * (unsigned)c + (unsigned)crow_) * (unsigned)D + (unsigned)(h * 64 + cpc));
#pragma unroll
              for (int i = 0; i < 4; ++i) { const u32x4 v_ = *(const LAS u32x4*)(wb + (crow_ + 8 * i) * KS_STRIDE + cpc); *(u32x4*)(op + (unsigned)(8 * i) * (unsigned)D) = v_; } }
            asm volatile("s_waitcnt lgkmcnt(0)" ::: "memory");
        }
#undef ATT_LOAD_QG
    }
#undef ATT_LOAD_KV
}

#define XB_TMO      128
#define XB_XCNT(j)  (256  + 64 * (j))
#define XB_XSUB(j)  (1280 + 64 * (j))
#define XB_XGEN(j)  (2304 + 64 * (j))
#define XB_TOP      3328
#define XB_TOPGEN   3392
#define XCD_BAR_WORDS 3456
#define XB_SPIN_CAP (1u << 22)
__device__ __forceinline__ unsigned xb_ld(unsigned* p)              { return __hip_atomic_load(p, __ATOMIC_RELAXED, __HIP_MEMORY_SCOPE_AGENT); }
__device__ __forceinline__ unsigned xb_add(unsigned* p, unsigned v) { return __hip_atomic_fetch_add(p, v, __ATOMIC_RELAXED, __HIP_MEMORY_SCOPE_AGENT); }
__device__ __forceinline__ unsigned xb_xcc_id() { return (unsigned)__builtin_amdgcn_s_getreg((3 << 11) | 20) & 0xFu; }
#define XB_SPIN(cond, bar) do { unsigned _sp = 0; while (cond) { __builtin_amdgcn_s_sleep(1); \
    if ((++_sp & 255u) == 0u) { if (xb_ld(&(bar)[XB_TMO])) break; if (_sp > XB_SPIN_CAP) { atomicAdd(&(bar)[XB_TMO], 1u); break; } } } } while (0)
#define XB_EXIT     3400
__device__ unsigned g_barrier_words[XCD_BAR_WORDS];
__device__ unsigned g_panel_cnt[128 * 16];
struct XcdBarrier { unsigned* bar; unsigned x; volatile LAS unsigned* st; };
__device__ __forceinline__ XcdBarrier xcd_barrier_post(unsigned* bar, volatile LAS unsigned* st) {
    XcdBarrier b; b.bar = bar; b.x = xb_xcc_id(); b.st = st;
    if (threadIdx.x == 0) (void)xb_add(&bar[XB_XCNT(b.x)], 1u);
    return b;
}
__device__ __forceinline__ void xcd_barrier_complete(unsigned* bar, unsigned x, unsigned& nloc, unsigned& nx) {
    const unsigned G = gridDim.x * gridDim.y * gridDim.z;
    unsigned sum, cnt, mine, sp = 0u;
    for (;;) {
        sum = 0u; cnt = 0u; mine = 0u;
#pragma unroll
        for (unsigned j = 0; j < 16; ++j) { const unsigned c = xb_ld(&bar[XB_XCNT(j)]); sum += c; cnt += (c > 0u) ? 1u : 0u; mine = (j == x) ? c : mine; }
        if (sum == G) break;
        __builtin_amdgcn_s_sleep(1);
        if ((++sp & 255u) == 0u) { if (xb_ld(&bar[XB_TMO])) break; if (sp > XB_SPIN_CAP) { atomicAdd(&bar[XB_TMO], 1u); break; } }
    }
    nloc = mine > 0u ? mine : 1u; nx = cnt > 0u ? cnt : 1u;
}
__device__ __forceinline__ void xcd_barrier(const XcdBarrier& b) {
    asm volatile("s_waitcnt vmcnt(0)" ::: "memory");
    __syncthreads();
    if (threadIdx.x == 0) {
        unsigned* bar = b.bar;
        __builtin_amdgcn_s_waitcnt(0);
        unsigned nloc = b.st[0], nx = b.st[1];
        if (nloc == 0u) { xcd_barrier_complete(bar, b.x, nloc, nx); b.st[0] = nloc; b.st[1] = nx; }
        const unsigned old = xb_add(&bar[XB_XSUB(b.x)], 1u);
        const unsigned gen = old / nloc;
        if (old + 1u == (gen + 1u) * nloc) {
            __builtin_amdgcn_fence(__ATOMIC_RELEASE, "agent");
            asm volatile("s_waitcnt vmcnt(0)" ::: "memory");
            const unsigned og = xb_add(&bar[XB_TOP], 1u);
            const unsigned tg = og / nx;
            if (og + 1u == (tg + 1u) * nx) xb_add(&bar[XB_TOPGEN], 1u);
            else XB_SPIN(xb_ld(&bar[XB_TOPGEN]) == tg, bar);
            __builtin_amdgcn_fence(__ATOMIC_ACQUIRE, "agent");
            xb_add(&bar[XB_XGEN(b.x)], 1u);
            asm volatile("s_waitcnt vmcnt(0)" ::: "memory");
        } else {
            XB_SPIN(xb_ld(&bar[XB_XGEN(b.x)]) == gen, bar);
            __builtin_amdgcn_fence(__ATOMIC_ACQUIRE, "agent");
            asm volatile("s_waitcnt vmcnt(0)" ::: "memory");
        }
    }
    __syncthreads();
}

constexpr int RSTD_OFF = 131072 + 1024;
constexpr int LDS_BYTES = 131072 + 1024 + 5 * 256 * 4 + 64;
__global__ void __launch_bounds__(512, 2) fwd_megakernel(Args a) {
    __builtin_assume(__builtin_amdgcn_workitem_id_y() == 0); __builtin_assume(__builtin_amdgcn_workitem_id_z() == 0);
    extern __shared__ __attribute__((aligned(16))) unsigned char lds_raw[];
    LAS unsigned char* lds = (LAS unsigned char*)lds_raw;
    cg::grid_group grid = cg::this_grid();
#define FRESH_TID(tid, lane, wave) int tid = threadIdx.x; asm volatile("" : "+v"(tid)); const int lane = tid & 63, wave = __builtin_amdgcn_readfirstlane(tid >> 6); (void)lane; (void)wave
    const int G = gridDim.x, bx = blockIdx.x;
    const int vcu = (G % 8 == 0) ? (bx % 8) * (G / 8) + bx / 8 : bx;
    const float* x = (const float*)a.in[0]; const int* pos = (const int*)a.in[1]; const float* norm_g = (const float*)a.in[2];
    const float* w_in_even = (const float*)a.in[3]; const float* w_pool = (const float*)a.in[4]; const float* pool_scale = (const float*)a.in[5];
    const float* conv_w = (const float*)a.in[6]; const float* w_out_even = (const float*)a.in[7]; const float* w_in_odd = (const float*)a.in[8];
    const float* b_in_odd = (const float*)a.in[9]; const float* sinks = (const float*)a.in[10]; const float* w_out_odd = (const float*)a.in[11];
    const float* b_out_odd = (const float*)a.in[12]; const float* final_g = (const float*)a.in[13];
    unsigned char* ws = a.ws;
    float* SS1 = (float*)(ws + WS_SS1); float* SS2 = (float*)(ws + WS_SS2); float* COS = (float*)(ws + WS_COS);
    bf16_t* WT1 = (bf16_t*)(ws + WS_WT1); bf16_t* WT2 = (bf16_t*)(ws + WS_WT2); bf16_t* WT3 = (bf16_t*)(ws + WS_WT3); bf16_t* WT4 = (bf16_t*)(ws + WS_WT4);
    bf16_t* XN = (bf16_t*)(ws + WS_XN); bf16_t* PROJ1 = (bf16_t*)(ws + WS_PROJ1); bf16_t* ATT = (bf16_t*)(ws + WS_ATT); bf16_t* CUS = (bf16_t*)(ws + WS_CUS); bf16_t* GZS = (bf16_t*)(ws + WS_GZS); bf16_t* U0 = (bf16_t*)(ws + WS_U0); bf16_t* Z0 = (bf16_t*)(ws + WS_Z0); bf16_t* UT = (bf16_t*)(ws + WS_UT);
    bf16_t* OUTB = (bf16_t*)a.out;
    const int lo = a.ph_lo, hi = a.ph_hi;
    volatile LAS unsigned* MISC = (volatile LAS unsigned*)(lds + 131072);
    if (threadIdx.x < 16) MISC[threadIdx.x] = 0u;
    __syncthreads();
    XcdBarrier bar; bar.bar = g_barrier_words; bar.x = 0; bar.st = MISC;
    if (hi - lo > 1) bar = xcd_barrier_post(g_barrier_words, MISC);
#define IN(k) (lo <= (k) && (k) < hi)
#define REP(k) for (int rep_ = 0; rep_ < (((a.rep_mask >> (k)) & 1) ? 2 : 1); ++rep_)
#define SEAM(k) do { if (IN(k) && IN((k) + 1)) xcd_barrier(bar); } while (0)

    if ((a.rep_mask >> 9) & 1) { for (int i_ = 0; i_ < 16; ++i_) grid.sync(); }
    if ((a.rep_mask >> 10) & 1) { for (int i_ = 0; i_ < 16; ++i_) xcd_barrier(bar); }
    if (IN(0)) REP(0) {
        FRESH_TID(tid, lane, wave);
        LAS float* scr = (LAS float*)(lds + wave * 16384);
        const int gw = vcu * 8 + wave, NGW = G * 8;
        constexpr int IF = 4 * 32 * 8;
        constexpr int NB1 = (EVEN_IN - 1024) / 32, I1 = (D / 64) * NB1;
        constexpr int NB2 = D / 32, I2 = (EVEN_W / 64) * NB2, NB3 = ODD_IN / 32, I3 = (D / 64) * NB3, NB4 = D / 32, I4 = (D / 64) * NB4;
        constexpr int NITEMS = IF + I1 + I2 + I3 + I4;
        for (int it = gw; it < NITEMS; it += NGW) {
            int r = it;
            if (r < IF) { p0_fold_item(w_in_even, w_pool, pool_scale, WT1, r, lane); continue; } r -= IF;
            if (r < I1) { const int n0 = 1024 + (r % NB1) * 32; p0_transpose_item(w_in_even, D, EVEN_IN, WT1, 0, scr, 64 * (r / NB1), n0, lane, nullptr, true); continue; } r -= I1;
            if (r < I2) { p0_transpose_item(w_out_even, EVEN_W, D, WT2, 0, scr, 64 * (r / NB2), 32 * (r % NB2), lane); continue; } r -= I2;
            if (r < I3) { p0_transpose_item(w_in_odd, D, ODD_IN, WT3, 0, scr, 64 * (r / NB3), 32 * (r % NB3), lane, norm_g + D); continue; } r -= I3;
            p0_transpose_item(w_out_odd, D, D, WT4, 0, scr, 64 * (r / NB4), 32 * (r % NB4), lane);
        }
        f32x4 gq[4];
#pragma unroll
        for (int j = 0; j < 4; ++j) gq[j] = *((const f32x4*)norm_g + lane + 64 * j);
        for (int mb = gw; mb < M; mb += 4 * NGW) {
            f32x4 v[4][4]; float sq[4];
#pragma unroll
            for (int q = 0; q < 4; ++q) { const f32x4* xr = (const f32x4*)(x + (size_t)(mb + q * NGW) * D) + lane;
#pragma unroll
                for (int j = 0; j < 4; ++j) v[q][j] = __builtin_nontemporal_load(xr + 64 * j); }
#pragma unroll
            for (int q = 0; q < 4; ++q) { float s_ = 0.f;
#pragma unroll
                for (int j = 0; j < 4; ++j) s_ += (v[q][j].x * v[q][j].x + v[q][j].y * v[q][j].y) + (v[q][j].z * v[q][j].z + v[q][j].w * v[q][j].w);
                sq[q] = s_; }
#pragma unroll
            for (int o = 1; o < 64; o <<= 1) {
#pragma unroll
                for (int q = 0; q < 4; ++q) sq[q] += __shfl_xor(sq[q], o); }
#pragma unroll
            for (int q = 0; q < 4; ++q) { const float ms = sq[q] * (1.f / D) + EPS; const float rstd = rsqrtf(ms);
                if (lane == 0) COS  [mb + q * NGW] = sqrtf(ms);
                u32x2* o8 = (u32x2*)(XN + (size_t)(mb + q * NGW) * D) + lane;
#pragma unroll
                for (int j = 0; j < 4; ++j) { u32x2 w; w.x = cvt_pk_bf16(v[q][j].x * rstd * gq[j].x, v[q][j].y * rstd * gq[j].y); w.y = cvt_pk_bf16(v[q][j].z * rstd * gq[j].z, v[q][j].w * rstd * gq[j].w); o8[64 * j] = w; } }
        }
        { float* ropec = (float*)(ws + WS_ROPEC); float* ropes = (float*)(ws + WS_ROPES);
          for (int idx = vcu * 512 + tid; idx < M * 8; idx += G * 512) {
              const float ang = (float)pos[idx >> 3] * INVF[idx & 7]; const float fr_ = __builtin_amdgcn_fractf(ang * 0.15915494309189535f);
              ropec[idx] = __builtin_amdgcn_cosf(fr_); ropes[idx] = __builtin_amdgcn_sinf(fr_); } }
        __syncthreads();
    }
    SEAM(0);
    if (IN(1)) REP(1) {
        pg8::Gemm g{XN, WT1, M, EVEN_IN, D, 0}; pg8::StaticOrder S; S.init(M, EVEN_IN, G, bx);
        pg8::EpiEven E{OUTB, CUS, GZS, U0, Z0, UT, conv_w};
        pg8::gemm_phase<pg8::EpiEven, true>(lds, g, S, E);
    }
    SEAM(1);
    if (IN(2)) REP(2) { FRESH_TID(tid, lane, wave); p2_phase(OUTB, CUS, GZS, U0, Z0, UT, conv_w, vcu * 512 + tid, G * 512); }
    if (IN(2) && IN(4)) xcd_barrier(bar);
    if (IN(4)) REP(4) {
        pg8::Gemm g{OUTB, WT2, M, D, EVEN_W, 0}; pg8::StaticOrder S; S.init(M, D, G, bx);
        pg8::EpiRes1 E{XN  , COS  , norm_g, SS1};
        pg8::gemm_phase(lds, g, S, E);
    }
    SEAM(4);
    if (IN(5)) REP(5) {
        pg8::Gemm g{XN, WT3, M, ODD_IN, D, 0}; pg8::StaticOrder S; S.init(M, ODD_IN, G, bx); if (G == 256) S.tail_round = 4;
        LAS float* rtab = (LAS float*)(lds + RSTD_OFF);
        { FRESH_TID(tid, lane, wave);
          for (int i = tid >> 8; i < 5; i += 2) { pg8::Unit u; if (!S.next(i, u)) break;
              const float* sp = SS1 + (size_t)(u.pm * 256 + (tid & 255)) * 16;
              const f32x4 s0 = *(const f32x4*)sp, s1 = *(const f32x4*)(sp + 4), s2 = *(const f32x4*)(sp + 8), s3 = *(const f32x4*)(sp + 12);
              const float tot = ((s0[0] + s0[1]) + (s0[2] + s0[3])) + ((s1[0] + s1[1]) + (s1[2] + s1[3])) + ((s2[0] + s2[1]) + (s2[2] + s2[3])) + ((s3[0] + s3[1]) + (s3[2] + s3[3]));
              rtab[i * 256 + (tid & 255)] = rsqrtf(tot * (1.0f / D) + EPS); }
          __syncthreads(); }
        pg8::EpiQKVZ E{PROJ1, b_in_odd, (const float*)(ws + WS_ROPEC), (const float*)(ws + WS_ROPES), rtab};
        pg8::gemm_phase<pg8::EpiQKVZ, false, true>(lds, g, S, E);
    }
    SEAM(5);
    if (IN(6)) REP(6) { attn_phase(lds, PROJ1, ATT, sinks, vcu, G); __syncthreads(); }
    SEAM(6);
    if (IN(7)) REP(7) {
        pg8::Gemm g{ATT, WT4, M, D, D, 0}; pg8::StaticOrder S; S.init(M, D, G, bx);
        pg8::EpiFinal E{XN  , a.out, b_out_odd, final_g, SS2  , g_panel_cnt, lds + RSTD_OFF};
        pg8::gemm_phase(lds, g, S, E);
    }
    if (hi - lo > 1) {
        __syncthreads();
        if (threadIdx.x == 0) { const unsigned old = xb_add(&g_barrier_words[XB_EXIT], 1u); MISC[4] = (old + 1u == (unsigned)gridDim.x) ? 1u : 0u; }
        __syncthreads();
        if (MISC[4] != 0u) {
            for (int i_ = threadIdx.x; i_ < XCD_BAR_WORDS; i_ += 512) __hip_atomic_store(&g_barrier_words[i_], 0u, __ATOMIC_RELAXED, __HIP_MEMORY_SCOPE_AGENT);
            for (int i_ = threadIdx.x; i_ < 128 * 16; i_ += 512) __hip_atomic_store(&g_panel_cnt[i_], 0u, __ATOMIC_RELAXED, __HIP_MEMORY_SCOPE_AGENT);
            __builtin_amdgcn_fence(__ATOMIC_RELEASE, "agent");
        }
    }
#undef IN
#undef SEAM
}

extern "C" void kernel_launch(void* const* d_in, const int* in_sizes, int n_in, void* d_out, int out_size, void* d_ws, size_t ws_size, hipStream_t stream) {
    static int grid = 0;
    if (grid == 0) {
        if (n_in != 14 || in_sizes[0] != M * D || out_size != M * D || ws_size < WS_END) {
            fprintf(stderr, "kernel_launch: shape/workspace mismatch (n_in %d, in0 %d, out %d, ws %zu); nothing launched\n", n_in, n_in > 0 ? in_sizes[0] : -1, out_size, ws_size); grid = -1; return; }
        int dev = 0, cus = 0, per_cu = 0;
        if (hipGetDevice(&dev) != hipSuccess || hipDeviceGetAttribute(&cus, hipDeviceAttributeMultiprocessorCount, dev) != hipSuccess) { grid = -1; return; }
        if (hipFuncSetAttribute((const void*)fwd_megakernel, hipFuncAttributeMaxDynamicSharedMemorySize, LDS_BYTES) != hipSuccess) { fprintf(stderr, "kernel_launch: hipFuncSetAttribute failed\n"); grid = -1; return; }
        if (hipOccupancyMaxActiveBlocksPerMultiprocessor(&per_cu, (const void*)fwd_megakernel, 512, LDS_BYTES) != hipSuccess || per_cu < 1) { fprintf(stderr, "kernel_launch: occupancy query says %d\n", per_cu); per_cu = 1; }
        (void)hipGetLastError();
        grid = cus * 1;
    }
    if (grid < 0) return;
    Args a{};
    for (int i = 0; i < 14; ++i) a.in[i] = d_in[i];
    a.out = (float*)d_out; a.ws = (unsigned char*)d_ws; a.rep_mask = PROBE_MASK;
#if MK_N_LAUNCHES == 1
    a.ph_lo = 0; a.ph_hi = 9;
    void* args[] = {&a};
    hipError_t e = hipLaunchCooperativeKernel((const void*)fwd_megakernel, dim3(grid), dim3(512), args, LDS_BYTES, stream);
    if (e != hipSuccess) fprintf(stderr, "cooperative launch failed: %s (grid %d)\n", hipGetErrorString(e), grid);
#else
    for (int p = 0; p < 9; ++p) { a.ph_lo = p; a.ph_hi = p + 1; hipLaunchKernelGGL(fwd_megakernel, dim3(grid), dim3(512), LDS_BYTES, stream, a); }
#endif
}
```
